# Optimizing an MI355X kernel written in HIP

```python
import jax, jax.numpy as jnp
from jax import lax
import numpy as np

D_MODEL = 1024
BATCH = 8
SEQ = 2048
DEPTH = 2

GRID_W = 64
CTX_LEN = 256
N_MIXERS = 2
EPS = 1e-6
N_ADA = 6
POOL_WINDOWS = (2, 4, 8, 16)
N_POOL_GROUPS = 4
POOL_GROUP_DIM = D_MODEL // N_POOL_GROUPS
MLSTM_HEADS = 8
QK_DIM = D_MODEL // 2
V_DIM = D_MODEL
DK = QK_DIM // MLSTM_HEADS
DV = V_DIM // MLSTM_HEADS
CHUNK = 64
IN_PROJ_DIM = 2 * QK_DIM + 2 * V_DIM + 4 * MLSTM_HEADS
N_EXPERTS = 16
CAPACITY_FACTOR = 2
EXPERT_HIDDEN = 2 * D_MODEL
N_POOL_LAYERS = (DEPTH + 1) // 2
N_MLSTM_LAYERS = DEPTH // 2

kernel_name = "hybrid_pool_mlstm_ecmoe_dit"


def _rmsnorm(x, g):
    xf = x.astype(jnp.float32)
    y = xf * lax.rsqrt(jnp.mean(xf * xf, axis=-1, keepdims=True) + EPS)
    return (y * g.astype(jnp.float32)).astype(x.dtype)


def _modulate(h, shift, scale):
    return h * (1 + scale) + shift


def _box_mean(x, axis, w):
    n = x.shape[axis]
    s = jnp.cumsum(x.astype(jnp.float32), axis=axis)
    s = jnp.concatenate([jnp.zeros_like(lax.slice_in_dim(s, 0, 1, axis=axis)), s], axis=axis)
    t = np.arange(n)
    lo = np.clip(t - w // 2, 0, n)
    hi = np.clip(t + w - w // 2, 0, n)
    tot = jnp.take(s, hi, axis=axis) - jnp.take(s, lo, axis=axis)
    cshape = [1] * x.ndim
    cshape[axis] = n
    cnt = jnp.asarray((hi - lo).astype(np.float32)).reshape(cshape)
    return (tot / cnt).astype(x.dtype)


def _pool_mixer(hx, hc, w_pool, scale, rows):
    B, L, D = hx.shape
    g = hx.reshape(B, rows, GRID_W, N_POOL_GROUPS, POOL_GROUP_DIM)
    pooled = jnp.stack([_box_mean(_box_mean(g[..., j, :], 2, w), 1, w)
                        for j, w in enumerate(POOL_WINDOWS)], axis=3)
    yx = jnp.einsum('brwgc,gcd->brwgd', pooled - g, w_pool).reshape(B, L, D) * scale
    if hc is None:
        return yx, None
    Lc = hc.shape[1]
    gc = hc.reshape(B, Lc, N_POOL_GROUPS, POOL_GROUP_DIM)
    pooled_c = jnp.stack([_box_mean(gc[..., j, :], 1, w) for j, w in enumerate(POOL_WINDOWS)], axis=2)
    yc = jnp.einsum('blgc,gcd->blgd', pooled_c - gc, w_pool).reshape(B, Lc, D) * scale
    return yx, yc


def _mlstm_scan(q, k, v, ig, lf, state):
    B, H, T, _ = q.shape
    nc = T // CHUNK

    def to_chunks(a):
        return jnp.moveaxis(a.reshape(a.shape[:2] + (nc, CHUNK) + a.shape[3:]), 2, 0)

    tril = jnp.asarray(np.tril(np.ones((CHUNK, CHUNK), dtype=bool)))

    def step(carry, inp):
        C, n, m = carry
        qc, kc, vc, ic, fc = inp
        b = jnp.cumsum(fc, axis=-1)
        a = b + m[..., None]
        dmat = jnp.where(tril, b[..., :, None] - b[..., None, :] + ic[..., None, :], -jnp.inf)
        mj = jnp.maximum(a, jnp.max(dmat, axis=-1))
        w_inter = jnp.exp(a - mj)
        s = jnp.einsum('bhjd,bhsd->bhjs', qc, kc) * jnp.exp(dmat - mj[..., None])
        num = jnp.einsum('bhjs,bhsv->bhjv', s, vc) + w_inter[..., None] * jnp.einsum('bhvd,bhjd->bhjv', C, qc)
        den = jnp.sum(s, axis=-1) + w_inter * jnp.einsum('bhd,bhjd->bhj', n, qc)
        h = num / jnp.maximum(jnp.abs(den), jnp.exp(-mj))[..., None]
        b_last = b[..., -1]
        gl = b_last[..., None] - b + ic
        m_new = jnp.maximum(b_last + m, jnp.max(gl, axis=-1))
        ws = jnp.exp(gl - m_new[..., None])
        decay = jnp.exp(b_last + m - m_new)
        C_new = decay[..., None, None] * C + jnp.einsum('bhs,bhsv,bhsd->bhvd', ws, vc, kc)
        n_new = decay[..., None] * n + jnp.einsum('bhs,bhsd->bhd', ws, kc)
        return (C_new, n_new, m_new), h

    state, hs = lax.scan(step, state, tuple(to_chunks(a) for a in (q, k, v, ig, lf)))
    h = jnp.moveaxis(hs, 0, 2).reshape(B, H, T, -1)
    return h, state


def _mlstm_project(h, w_in, b_gates):
    B, T, _ = h.shape
    p = h @ w_in

    def heads(a, d):
        return jnp.swapaxes(a.reshape(B, T, MLSTM_HEADS, d), 1, 2).astype(jnp.float32)

    q = heads(p[..., :QK_DIM], DK)
    k = heads(p[..., QK_DIM:2 * QK_DIM], DK) * (DK ** -0.5)
    v = heads(p[..., 2 * QK_DIM:2 * QK_DIM + V_DIM], DV)
    o = jax.nn.sigmoid(p[..., 2 * QK_DIM + V_DIM:2 * QK_DIM + 2 * V_DIM])
    gates = (p[..., 2 * QK_DIM + 2 * V_DIM:] + b_gates).astype(jnp.float32)
    gates = gates.reshape(B, T, 4, MLSTM_HEADS).transpose(2, 0, 3, 1)
    return q, k, v, o, gates


def _mlstm_out(h, o, norm_g, w_out):
    B, H, T, _ = h.shape
    h = h * lax.rsqrt(jnp.mean(h * h, axis=-1, keepdims=True) + EPS)
    h = jnp.swapaxes(h, 1, 2).reshape(B, T, V_DIM) * norm_g.astype(jnp.float32)
    return (h.astype(o.dtype) * o) @ w_out


def _mlstm_mixer(hx, hc, w_in, b_gates, norm_g, w_out, ctx_out):
    B = hx.shape[0]
    qx, kx, vx, ox, gx = _mlstm_project(hx, w_in, b_gates)
    qc, kc, vc, oc, gc = _mlstm_project(hc, w_in, b_gates)
    zero = (jnp.zeros((B, MLSTM_HEADS, DV, DK), jnp.float32),
            jnp.zeros((B, MLSTM_HEADS, DK), jnp.float32),
            jnp.zeros((B, MLSTM_HEADS), jnp.float32))
    ls = jax.nn.log_sigmoid

    def flip(a):
        return jnp.flip(a, axis=2)

    hc_f, st_f = _mlstm_scan(qc, kc, vc, gc[0], ls(gc[1]), zero)
    hx_f, _ = _mlstm_scan(qx, kx, vx, gx[0], ls(gx[1]), st_f)
    hc_b, st_b = _mlstm_scan(flip(qc), flip(kc), flip(vc), flip(gc[2]), flip(ls(gc[3])), zero)
    hx_b, _ = _mlstm_scan(flip(qx), flip(kx), flip(vx), flip(gx[2]), flip(ls(gx[3])), st_b)
    yx = _mlstm_out(hx_f + flip(hx_b), ox, norm_g, w_out)
    yc = _mlstm_out(hc_f + flip(hc_b), oc, norm_g, w_out) if ctx_out else None
    return yx, yc


def _ec_moe(h, w_router, w_gate, w_up, w_down):
    B, T, D = h.shape
    cap = CAPACITY_FACTOR * T // N_EXPERTS
    aff = jax.nn.softmax(jnp.einsum('btd,de->bte', h, w_router).astype(jnp.float32), axis=-1)
    gate, idx = lax.top_k(jnp.swapaxes(aff, 1, 2), cap)
    xs = jax.vmap(lambda hb, ib: hb[ib])(h, idx)
    hid = jax.nn.silu(jnp.einsum('becd,edf->becf', xs, w_gate)) * jnp.einsum('becd,edf->becf', xs, w_up)
    ys = jnp.einsum('becf,efd->becd', hid, w_down) * gate[..., None].astype(h.dtype)
    return jax.vmap(lambda yb, ib: jnp.zeros((T, D), yb.dtype).at[ib.reshape(-1)].add(yb.reshape(-1, D)))(ys, idx)


def setup_inputs(seed: int = 0) -> dict:
    key = jax.random.key(seed)
    ks = jax.random.split(key, 19)

    def nrm(k, shape, s):
        return jax.random.normal(k, shape, jnp.float32) * s

    D = D_MODEL
    gate_offset = jnp.repeat(jnp.array([0.0, 3.0, 0.0, 3.0], jnp.float32), MLSTM_HEADS)
    return {
        "x": nrm(ks[0], (BATCH, SEQ, D), 1.0),
        "c": nrm(ks[1], (BATCH, D), 1.0),
        "ctx": nrm(ks[2], (BATCH, CTX_LEN, D), 1.0),
        "c_ctx": nrm(ks[3], (D,), 1.0),
        "ada_w": nrm(ks[4], (DEPTH, D, N_ADA * D), 0.5 * D ** -0.5),
        "ada_b": nrm(ks[5], (DEPTH, N_ADA * D), 0.02),
        "norm_mix": 1.0 + nrm(ks[6], (DEPTH, D), 0.02),
        "norm_ffn": 1.0 + nrm(ks[7], (DEPTH, D), 0.02),
        "pool_w": nrm(ks[8], (N_POOL_LAYERS, N_POOL_GROUPS, POOL_GROUP_DIM, POOL_GROUP_DIM), POOL_GROUP_DIM ** -0.5),
        "pool_scale": 1.0 + nrm(ks[9], (N_POOL_LAYERS, D), 0.1),
        "mlstm_w_in": nrm(ks[10], (N_MLSTM_LAYERS, D, IN_PROJ_DIM), D ** -0.5),
        "mlstm_b_gates": gate_offset[None] + nrm(ks[11], (N_MLSTM_LAYERS, 4 * MLSTM_HEADS), 0.1),
        "mlstm_norm": 1.0 + nrm(ks[12], (N_MLSTM_LAYERS, V_DIM), 0.02),
        "mlstm_w_out": nrm(ks[13], (N_MLSTM_LAYERS, V_DIM, D), V_DIM ** -0.5),
        "moe_router": nrm(ks[14], (DEPTH, D, N_EXPERTS), D ** -0.5),
        "moe_w_gate": nrm(ks[15], (DEPTH, N_EXPERTS, D, EXPERT_HIDDEN), D ** -0.5),
        "moe_w_up": nrm(ks[16], (DEPTH, N_EXPERTS, D, EXPERT_HIDDEN), D ** -0.5),
        "moe_w_down": nrm(ks[17], (DEPTH, N_EXPERTS, EXPERT_HIDDEN, D), EXPERT_HIDDEN ** -0.5),
        "final_norm": 1.0 + nrm(ks[18], (D,), 0.02),
    }


def reference(x, c, ctx, c_ctx, ada_w, ada_b, norm_mix, norm_ffn, pool_w, pool_scale,
              mlstm_w_in, mlstm_b_gates, mlstm_norm, mlstm_w_out,
              moe_router, moe_w_gate, moe_w_up, moe_w_down, final_norm):
    rows = x.shape[1] // GRID_W
    for i in range(DEPTH):
        last = i == DEPTH - 1
        j = i // N_MIXERS
        mx = jnp.split((jax.nn.silu(c) @ ada_w[i] + ada_b[i])[:, None, :], N_ADA, axis=-1)
        mc = jnp.split(jax.nn.silu(c_ctx) @ ada_w[i] + ada_b[i], N_ADA, axis=-1)
        hx = _modulate(_rmsnorm(x, norm_mix[i]), mx[0], mx[1])
        if i % N_MIXERS == 0:
            hc = None if last else _modulate(_rmsnorm(ctx, norm_mix[i]), mc[0], mc[1])
            yx, yc = _pool_mixer(hx, hc, pool_w[j], pool_scale[j], rows)
        else:
            hc = _modulate(_rmsnorm(ctx, norm_mix[i]), mc[0], mc[1])
            yx, yc = _mlstm_mixer(hx, hc, mlstm_w_in[j], mlstm_b_gates[j], mlstm_norm[j], mlstm_w_out[j],
                                  ctx_out=not last)
        x = x + mx[2] * yx
        hx = _modulate(_rmsnorm(x, norm_ffn[i]), mx[3], mx[4])
        x = x + mx[5] * _ec_moe(hx, moe_router[i], moe_w_gate[i], moe_w_up[i], moe_w_down[i])
        if not last:
            ctx = ctx + mc[2] * yc
            hc = _modulate(_rmsnorm(ctx, norm_ffn[i]), mc[3], mc[4])
            ctx = ctx + mc[5] * _ec_moe(hc, moe_router[i], moe_w_gate[i], moe_w_up[i], moe_w_down[i])
    return _rmsnorm(x, final_norm)
```

```cpp
#include <hip/hip_runtime.h>
#include <cstdint>
#include <cstdio>

#define LAS __attribute__((address_space(3)))
typedef unsigned short bf16_t;
typedef short bf16x8 __attribute__((ext_vector_type(8)));
typedef short bf16x4 __attribute__((ext_vector_type(4)));
typedef float f32x4 __attribute__((ext_vector_type(4)));
typedef float f32x2 __attribute__((ext_vector_type(2)));
typedef unsigned u32x4 __attribute__((ext_vector_type(4)));
typedef unsigned u32x2 __attribute__((ext_vector_type(2)));

constexpr int D = 1024, NB = 8, T = 2048, TC = 256, NX = NB * T, NCX = NB * TC, NR = NX + NCX;
constexpr int NE = 16, FH = 2048, CAPX = 256, CAPC = 32;
constexpr int NH = 8, DK = 64, DV = 128, NIN = 3104, NINP = 3328, NQKVO = 3072;
constexpr int NADA = 6 * D;
constexpr float EPS = 1e-6f;
constexpr int NTHR = 512;
constexpr int NUNITM = 144;
constexpr int LDS_BYTES = 147456;

constexpr size_t al256(size_t x) { return (x + 255) & ~(size_t)255; }
constexpr size_t WS_CTL = 0;
constexpr size_t WS_MOD = 1u << 20;
constexpr size_t WS_RSX = WS_MOD + al256((size_t)2 * 9 * NADA * 4);
constexpr size_t WS_AFF = WS_RSX + al256((size_t)NR * 4);
constexpr size_t WS_AFFC = WS_AFF + (size_t)NB * NE * T * 4;
constexpr size_t WS_POS = WS_AFFC + (size_t)NB * NE * TC * 4;
constexpr size_t WS_POSC = WS_POS + (size_t)NB * NE * T * 4;
constexpr size_t WS_ROWTAB = WS_POSC + (size_t)NB * NE * TC * 4;
constexpr size_t WS_GATES = WS_ROWTAB + (size_t)NUNITM * 256 * 4;
constexpr size_t WS_GBUF = WS_GATES + (size_t)NR * 32 * 4;
constexpr int GB_STRIDE = 1040;
constexpr size_t WS_NLOC = WS_GBUF + (size_t)NB * NH * 9 * GB_STRIDE * 4;
constexpr size_t WS_NSTAR = WS_NLOC + (size_t)128 * 9 * 64 * 4;
constexpr size_t WS_RBUF = WS_NSTAR + (size_t)128 * 8 * 64 * 4;
constexpr size_t WS_POOLWT = al256(WS_RBUF + 128 * 8 * 4);
constexpr size_t WS_WINT = WS_POOLWT + (size_t)4 * 256 * 256 * 2;
constexpr size_t WS_WOUTT = WS_WINT + (size_t)NINP * D * 2;
constexpr size_t WS_WGUT = WS_WOUTT + (size_t)D * D * 2;
constexpr size_t WS_WDT = WS_WGUT + (size_t)2 * NE * 4096 * D * 2;
constexpr size_t WS_XA = WS_WDT + (size_t)2 * NE * D * FH * 2;
constexpr size_t WS_XB = WS_XA + (size_t)NR * D * 4;
constexpr size_t WS_ABF = WS_XB + (size_t)NR * D * 4;
constexpr size_t WS_BIG = WS_ABF + (size_t)NR * D * 2;
constexpr size_t WS_YS = WS_BIG + (size_t)NUNITM * 256 * FH * 2;
constexpr size_t WS_KLOC = WS_YS;
constexpr size_t WS_CSTAR = WS_KLOC + (size_t)128 * 9 * 8192 * 4;
constexpr size_t WS_END = WS_YS + (size_t)NUNITM * 256 * D * 2;
static_assert(WS_CSTAR + (size_t)128 * 8 * 8192 * 2 <= WS_END, "ws map");
static_assert(WS_END <= ((size_t)1 << 30), "ws fits 1 GiB");

struct Params {
    const float *x, *c, *ctx, *c_ctx, *ada_w, *ada_b, *norm_mix, *norm_ffn, *pool_w, *pool_scale, *w_in, *b_gates, *mlstm_norm, *w_out,
                *router, *w_gate, *w_up, *w_down, *final_norm;
    float* out;
    unsigned char* ws;
};

__device__ __forceinline__ unsigned f2bf(float f) { unsigned u = __builtin_bit_cast(unsigned, f); return (u + 0x7fffu + ((u >> 16) & 1u)) >> 16; }
typedef __bf16 bf16n2 __attribute__((ext_vector_type(2)));
__device__ __forceinline__ unsigned pk2(float lo, float hi) { return __builtin_bit_cast(unsigned, __builtin_convertvector((f32x2){lo, hi}, bf16n2)); }
typedef _Float16 f16n2 __attribute__((ext_vector_type(2)));
__device__ __forceinline__ unsigned pkr(float lo, float hi) { return __builtin_bit_cast(unsigned, __builtin_convertvector((f32x2){lo, hi}, f16n2)); }
__device__ __forceinline__ f32x2 unr(unsigned w) { return __builtin_convertvector(__builtin_bit_cast(f16n2, w), f32x2); }
__device__ __forceinline__ float bf2f(unsigned short h) { return __builtin_bit_cast(float, (unsigned)h << 16); }
__device__ __forceinline__ float wave_sum(float v) {
#pragma unroll
    for (int o = 1; o < 64; o <<= 1) v += __shfl_xor(v, o);
    return v;
}
typedef int v8i32 __attribute__((ext_vector_type(8)));
constexpr float ACT_SCALE = 8.f, W_SCALE = 64.f, HID_SCALE = 8.f;
__device__ __forceinline__ float clamp448(float v) { return __builtin_amdgcn_fmed3f(v, -448.f, 448.f); }
__device__ __forceinline__ unsigned pk4_fp8(float a, float b, float c, float d) {
    int w = 0;
    w = __builtin_amdgcn_cvt_pk_fp8_f32(clamp448(a), clamp448(b), w, false);
    w = __builtin_amdgcn_cvt_pk_fp8_f32(clamp448(c), clamp448(d), w, true);
    return (unsigned)w;
}
__device__ __forceinline__ int otid() { int t = threadIdx.x; asm volatile("" : "+v"(t)); return t; }
__device__ __forceinline__ float siluf(float v) { return v * __builtin_amdgcn_rcpf(1.f + __expf(-v)); }
__device__ __forceinline__ float sigmoidf(float v) { return __builtin_amdgcn_rcpf(1.f + __expf(-v)); }
__device__ __forceinline__ float logsigmoidf(float v) { return fminf(v, 0.f) - log1pf(__expf(-fabsf(v))); }
__device__ __forceinline__ int pool_w_of_group(int j) { return 2 << j; }

struct Unit { int pm, pb, pn, koff; };
struct GemmDesc { const bf16_t* A; int lda; const int* rowtab; const bf16_t* Bt; int ldb; int K; };
__device__ __forceinline__ int perm32(int rho) { const int n = rho >> 4, i = rho & 15; return 8 * (i >> 2) + 4 * n + (i & 3); }

template <class Epi, class Sched>
__device__ __forceinline__ void gemm_simple(LAS unsigned char* lds, const GemmDesc g, const Sched& S, const Epi& E) {
    const int tid = otid(), wid = __builtin_amdgcn_readfirstlane(tid >> 6), lane = tid & 63, wr = wid >> 2, wc = wid & 3, fr = lane & 15, fq = lane >> 4;
    constexpr int PITCH = 72;
    LAS bf16_t* As = (LAS bf16_t*)lds;
    LAS bf16_t* Bs = As + 256 * PITCH;
    Unit u;
    for (int ui = 0; S.next(ui, u); ++ui) {
        f32x4 acc[2][2][4][2];
#pragma unroll
        for (int a = 0; a < 2; ++a)
#pragma unroll
            for (int b = 0; b < 2; ++b)
#pragma unroll
                for (int m = 0; m < 4; ++m)
#pragma unroll
                    for (int n = 0; n < 2; ++n) acc[a][b][m][n] = (f32x4){0.f, 0.f, 0.f, 0.f};
        size_t aoff[4], boff[4]; int lof[4];
#pragma unroll
        for (int i = 0; i < 4; ++i) {
            const int piece = tid + NTHR * i, row = piece >> 3, cs = piece & 7;
            const int arow = g.rowtab ? g.rowtab[u.pm * 256 + row] : u.pm * 256 + row;
            aoff[i] = (size_t)arow * g.lda + u.koff + cs * 8;
            const int brow = u.pb * 256 + (row & ~31) + perm32(row & 31);
            boff[i] = (size_t)brow * g.ldb + cs * 8;
            lof[i] = row * PITCH + cs * 8;
        }
        for (int kt = 0; kt < g.K; kt += 64) {
            u32x4 av[4], bv[4];
#pragma unroll
            for (int i = 0; i < 4; ++i) { av[i] = *(const u32x4*)(g.A + aoff[i] + kt); bv[i] = *(const u32x4*)(g.Bt + boff[i] + kt); }
            __syncthreads();
#pragma unroll
            for (int i = 0; i < 4; ++i) { *(LAS u32x4*)(As + lof[i]) = av[i]; *(LAS u32x4*)(Bs + lof[i]) = bv[i]; }
            __syncthreads();
#pragma unroll
            for (int k = 0; k < 2; ++k) {
                bf16x8 Af[2][4], Bf[2][2];
#pragma unroll
                for (int ai = 0; ai < 2; ++ai)
#pragma unroll
                    for (int m = 0; m < 4; ++m) Af[ai][m] = *(const LAS bf16x8*)(As + (128 * ai + 64 * wr + 16 * m + fr) * PITCH + 32 * k + 8 * fq);
#pragma unroll
                for (int bj = 0; bj < 2; ++bj)
#pragma unroll
                    for (int n = 0; n < 2; ++n) Bf[bj][n] = *(const LAS bf16x8*)(Bs + (128 * bj + 32 * wc + 16 * n + fr) * PITCH + 32 * k + 8 * fq);
#pragma unroll
                for (int ai = 0; ai < 2; ++ai)
#pragma unroll
                    for (int bj = 0; bj < 2; ++bj)
#pragma unroll
                        for (int m = 0; m < 4; ++m)
#pragma unroll
                            for (int n = 0; n < 2; ++n) acc[ai][bj][m][n] = __builtin_amdgcn_mfma_f32_16x16x32_bf16(Bf[bj][n], Af[ai][m], acc[ai][bj][m][n], 0, 0, 0);
            }
        }
        E(acc, u, wr, wc, fr, fq);
        __syncthreads();
    }
}


constexpr int HTB = 128 * 64 * 2, STAGE_BYTES = 8 * HTB, TAB_OFF = STAGE_BYTES;
__device__ __forceinline__ int lds_byte(int r, int c) { const int st = (r >> 4) * 2 + (c >> 5), rr = r & 15, cc = c & 31, ob = rr * 64 + cc * 2; return st * 1024 + (ob ^ (((ob >> 9) & 1) << 5)); }
__device__ __forceinline__ void stage_rc(int b, int& R, int& C) { const int st = b / 1024, sb = b % 1024, swz = sb ^ (((sb >> 9) & 1) << 5); R = (st >> 1) * 16 + swz / 64; C = (st & 1) * 32 + (swz % 64) / 2; }

struct GpLead { static constexpr bool value = true; }; struct GpTrail { static constexpr bool value = false; };
template <bool FP8, class Epi, class Sched>
__device__ __forceinline__ void gemm_pipe(LAS unsigned char* lds, const GemmDesc g, const Sched& S, const Epi& E) {
    constexpr int ESZ = FP8 ? 1 : 2;
    const int tid = otid(), wid = __builtin_amdgcn_readfirstlane(tid >> 6), lane = tid & 63, wr = wid >> 2, wc = wid & 3, fr = lane & 15, fq = lane >> 4;
    const int nt = g.K * ESZ / 128;
    int R0, C0; stage_rc(tid * 16, R0, C0);
    const int rc = R0 | (C0 << 8);
    unsigned voffB[2];
    { const int Rb = (R0 & ~31) + perm32(R0 & 31); voffB[0] = (unsigned)(Rb * g.ldb * ESZ + C0 * 2); voffB[1] = voffB[0] + (unsigned)(64 * g.ldb * ESZ); }
    Unit cur, nxt; int ui = 0;
    if (!S.next(0, cur)) return;
    LAS int* tab = (LAS int*)(lds + TAB_OFF);
    if (g.rowtab) {
        Unit u; int tv[5];
#pragma unroll
        for (int k2 = 0; k2 < 5; ++k2) { const int k = 2 * k2 + (tid >> 8); tv[k2] = (k < 9 && S.next(k, u)) ? g.rowtab[u.pm * 256 + (tid & 255)] : 0; }
#pragma unroll
        for (int k2 = 0; k2 < 5; ++k2) { const int k = 2 * k2 + (tid >> 8); if (k < 9) tab[k * 256 + (tid & 255)] = tv[k2]; }
        asm volatile("s_waitcnt vmcnt(0) lgkmcnt(0)" ::: "memory");
        __syncthreads();
    }
    unsigned VA[2][2];
#define GP_LOAD_VA(k_, u_) do { _Pragma("unroll") for (int _h = 0; _h < 2; ++_h) _Pragma("unroll") for (int _i = 0; _i < 2; ++_i) { const int _rr = _h * 128 + 64 * _i + (rc & 255); \
        const int _ar = g.rowtab ? tab[(k_) * 256 + _rr] : (u_).pm * 256 + _rr; VA[_h][_i] = (unsigned)((_ar * g.lda + (u_).koff) * ESZ + (rc >> 8) * 2); } } while (0)
    GP_LOAD_VA(0, cur);
    const size_t kstep = 128;
    const size_t hstepB = (size_t)128 * g.ldb * ESZ;
    const size_t tstepB = 2 * hstepB;
    const unsigned ldsw = (unsigned)wid * 1024u;
    const int aoff = lds_byte(wr * 64 + fr, fq * 8), boff = lds_byte(wc * 32 + fr, fq * 8);
#define GP_SA(b, h) (((b) * 2 + (h)) * HTB)
#define GP_SB(b, h) ((4 + (b) * 2 + (h)) * HTB)
#define GP_STG_B(bufoff, gbase) do { _Pragma("unroll") for (int _i = 0; _i < 2; ++_i) \
        __builtin_amdgcn_global_load_lds((const unsigned*)((const char*)(gbase) + voffB[_i]), (LAS unsigned*)(lds + (bufoff) + ldsw + _i * 8192), 16, 0, 0); } while (0)
#define GP_STG_A(bufoff, gbase, h) do { _Pragma("unroll") for (int _i = 0; _i < 2; ++_i) \
        __builtin_amdgcn_global_load_lds((const unsigned*)((const char*)(gbase) + VA[h][_i]), (LAS unsigned*)(lds + (bufoff) + ldsw + _i * 8192), 16, 0, 0); } while (0)
#define GP_LDA(dst, b, h) do { _Pragma("unroll") for (int m = 0; m < 4; ++m) _Pragma("unroll") for (int k = 0; k < 2; ++k) dst[m][k] = *(const LAS bf16x8*)(lds + GP_SA(b, h) + aoff + m * 2048 + k * 1024); } while (0)
#define GP_LDB(dst, b, h) do { _Pragma("unroll") for (int n = 0; n < 2; ++n) _Pragma("unroll") for (int k = 0; k < 2; ++k) dst[n][k] = *(const LAS bf16x8*)(lds + GP_SB(b, h) + boff + n * 2048 + k * 1024); } while (0)
#define GP_CAT(x) __builtin_shufflevector(__builtin_bit_cast(u32x4, (x)[0]), __builtin_bit_cast(u32x4, (x)[1]), 0, 1, 2, 3, 4, 5, 6, 7)
#define GP_MMA(ai, bj, At, Bt) do { __builtin_amdgcn_s_setprio(1); _Pragma("unroll") for (int m = 0; m < 4; ++m) _Pragma("unroll") for (int n = 0; n < 2; ++n) { \
        if constexpr (FP8) acc[ai][bj][m][n] = __builtin_amdgcn_mfma_scale_f32_16x16x128_f8f6f4(__builtin_bit_cast(v8i32, GP_CAT(Bt[n])), __builtin_bit_cast(v8i32, GP_CAT(At[m])), acc[ai][bj][m][n], 0, 0, 0, Epi::MSCALE, 0, 0x7f7f7f7f); \
        else { _Pragma("unroll") for (int k = 0; k < 2; ++k) acc[ai][bj][m][n] = __builtin_amdgcn_mfma_f32_16x16x32_bf16(Bt[n][k], At[m][k], acc[ai][bj][m][n], 0, 0, 0); } } \
        __builtin_amdgcn_s_setprio(0); } while (0)
#define GP_WAIT_V(n) asm volatile("s_waitcnt vmcnt(" #n ")" ::: "memory")
#define GP_WAIT_L(n) asm volatile("s_waitcnt lgkmcnt(" #n ")" ::: "memory")
#define GP_WAIT_LT do { if constexpr (!LEAD) GP_WAIT_L(0); } while (0)
#define GP_BAR __builtin_amdgcn_s_barrier()
#define GP_SCHED __builtin_amdgcn_sched_barrier(0)
    auto body = [&](auto leadc) __attribute__((always_inline)) {
    constexpr bool LEAD = decltype(leadc)::value;
    f32x4 acc[2][2][4][2];
#pragma unroll
    for (int a = 0; a < 2; ++a)
#pragma unroll
        for (int b = 0; b < 2; ++b)
#pragma unroll
            for (int m = 0; m < 4; ++m)
#pragma unroll
                for (int n = 0; n < 2; ++n) acc[a][b][m][n] = (f32x4){0.f, 0.f, 0.f, 0.f};
    bf16x8 At[4][2], B0[2][2], B1[2][2];
    const char* A0 = (const char*)g.A;
    const char* cB = (const char*)g.Bt + (size_t)cur.pb * tstepB;
    GP_STG_B(GP_SB(0, 0), cB); GP_STG_B(GP_SB(0, 1), cB + hstepB); GP_STG_A(GP_SA(0, 0), A0, 0); GP_STG_A(GP_SA(0, 1), A0, 1);
    if (wr == 1) GP_BAR;
    GP_WAIT_V(2); GP_BAR;
    GP_STG_B(GP_SB(1, 0), cB + kstep); GP_STG_A(GP_SA(1, 0), A0 + kstep, 0); GP_STG_B(GP_SB(1, 1), cB + hstepB + kstep);
    GP_WAIT_V(6); GP_BAR;
    for (;;) {
        const bool has_next = S.next(ui + 1, nxt);
        const char* nB = has_next ? (const char*)g.Bt + (size_t)nxt.pb * tstepB : cB;
#pragma unroll 1
        for (int t = 0; t < nt; t += 2) {
            const bool last = (t == nt - 2);
            const char* a1 = A0 + (size_t)(t + 1) * kstep;
            const char* a2 = last ? A0 : A0 + (size_t)(t + 2) * kstep; const char* b2 = last ? nB : cB + (size_t)(t + 2) * kstep;
            const char* a3 = a2 + kstep; const char* b3 = b2 + kstep;
            if constexpr (FP8 && LEAD) { GP_LDB(B0, 0, 0); GP_SCHED; GP_LDA(At, 0, 0); } else { GP_LDB(B0, 0, 0); GP_LDB(B1, 0, 1); GP_SCHED; GP_LDA(At, 0, 0); }
            GP_STG_A(GP_SA(1, 1), a1, 1);
            if (last && has_next) GP_LOAD_VA(ui + 1, nxt);
            GP_WAIT_V(8); GP_WAIT_LT; GP_BAR;
            if constexpr (FP8 && LEAD) { GP_LDB(B1, 0, 1); GP_SCHED; GP_MMA(0, 0, At, B0); GP_MMA(0, 1, At, B1); } else { GP_MMA(0, 0, At, B0); GP_MMA(0, 1, At, B1); }
            GP_BAR; GP_SCHED;
            GP_LDA(At, 0, 1); GP_STG_B(GP_SB(0, 0), b2); GP_STG_B(GP_SB(0, 1), b2 + hstepB); GP_STG_A(GP_SA(0, 0), a2, 0);
            GP_WAIT_V(8); GP_WAIT_LT; GP_BAR; GP_MMA(1, 0, At, B0); GP_MMA(1, 1, At, B1); GP_BAR; GP_SCHED;
            if constexpr (FP8 && LEAD) { GP_LDB(B0, 1, 0); GP_SCHED; GP_LDA(At, 1, 0); } else { GP_LDB(B0, 1, 0); GP_LDB(B1, 1, 1); GP_SCHED; GP_LDA(At, 1, 0); }
            GP_STG_A(GP_SA(0, 1), a2, 1);
            GP_WAIT_V(8); GP_WAIT_LT; GP_BAR;
            if constexpr (FP8 && LEAD) { GP_LDB(B1, 1, 1); GP_SCHED; GP_MMA(0, 0, At, B0); GP_MMA(0, 1, At, B1); } else { GP_MMA(0, 0, At, B0); GP_MMA(0, 1, At, B1); }
            GP_BAR; GP_SCHED;
            GP_LDA(At, 1, 1); GP_STG_B(GP_SB(1, 0), b3); GP_STG_B(GP_SB(1, 1), b3 + hstepB); GP_STG_A(GP_SA(1, 0), a3, 0);
            GP_WAIT_V(8); GP_WAIT_LT; GP_BAR; GP_MMA(1, 0, At, B0); GP_MMA(1, 1, At, B1); GP_BAR; GP_SCHED;
        }
        if (wr == 0) GP_BAR;
        E(acc, cur, wr, wc, fr, fq);
        if (!has_next) break;
#pragma unroll
        for (int a = 0; a < 2; ++a)
#pragma unroll
            for (int b = 0; b < 2; ++b)
#pragma unroll
                for (int m = 0; m < 4; ++m)
#pragma unroll
                    for (int n = 0; n < 2; ++n) acc[a][b][m][n] = (f32x4){0.f, 0.f, 0.f, 0.f};
        cur = nxt; cB = nB; ++ui;
        if (wr == 1) GP_BAR;
    }
    GP_WAIT_V(0);
    GP_BAR;
    };
    if (wr == 0) body(GpLead{}); else body(GpTrail{});
#undef GP_LOAD_VA
#undef GP_SA
#undef GP_SB
#undef GP_STG_A
#undef GP_STG_B
#undef GP_LDA
#undef GP_LDB
#undef GP_MMA
#undef GP_CAT
#undef GP_WAIT_V
#undef GP_WAIT_L
#undef GP_WAIT_LT
#undef GP_BAR
#undef GP_SCHED
}

struct EpiBf16 {
    bf16_t* O; int ldo;
    __device__ __forceinline__ void operator()(const f32x4 (&acc)[2][2][4][2], const Unit& u, int wr, int wc, int fr_, int fq_) const {
        const int lane_ = otid() & 63, fr = lane_ & 15, fq = lane_ >> 4;
#pragma unroll
        for (int ai = 0; ai < 2; ++ai)
#pragma unroll
            for (int m = 0; m < 4; ++m) {
                bf16_t* rowp = O + (size_t)(u.pm * 256 + 128 * ai + 64 * wr + 16 * m + fr) * ldo + u.pn * 256 + 32 * wc + 8 * fq;
#pragma unroll
                for (int bj = 0; bj < 2; ++bj) { const f32x4 v0 = acc[ai][bj][m][0], v1 = acc[ai][bj][m][1];
                    u32x4 w; w.x = pk2(v0[0], v0[1]); w.y = pk2(v0[2], v0[3]); w.z = pk2(v1[0], v1[1]); w.w = pk2(v1[2], v1[3]);
                    *(u32x4*)(rowp + 128 * bj) = w; }
            }
    }
};
struct EpiSwiglu {
    bf16_t* O;
    __device__ __forceinline__ void operator()(const f32x4 (&acc)[2][2][4][2], const Unit& u, int wr, int wc, int fr_, int fq_) const {
        const int lane_ = otid() & 63, fr = lane_ & 15, fq = lane_ >> 4;
#pragma unroll
        for (int ai = 0; ai < 2; ++ai)
#pragma unroll
            for (int m = 0; m < 4; ++m) {
                bf16_t* rowp = O + (size_t)(u.pm * 256 + 128 * ai + 64 * wr + 16 * m + fr) * FH + u.pn * 128 + 32 * wc + 8 * fq;
                float h[8];
#pragma unroll
                for (int n = 0; n < 2; ++n)
#pragma unroll
                    for (int r = 0; r < 4; ++r) h[4 * n + r] = siluf(acc[ai][0][m][n][r]) * acc[ai][1][m][n][r];
                u32x4 w; w.x = pk2(h[0], h[1]); w.y = pk2(h[2], h[3]); w.z = pk2(h[4], h[5]); w.w = pk2(h[6], h[7]);
                *(u32x4*)rowp = w;
            }
    }
};
struct EpiSwigluF8 {
    static constexpr int MSCALE = 0x76767676;
    unsigned char* O;
    __device__ __forceinline__ void operator()(const f32x4 (&acc)[2][2][4][2], const Unit& u, int wr, int wc, int fr_, int fq_) const {
        const int lane_ = otid() & 63, fr = lane_ & 15, fq = lane_ >> 4;
        static_assert(ACT_SCALE * W_SCALE == 512.f, "MSCALE");
        constexpr float ih = 1.f / HID_SCALE;
#pragma unroll
        for (int ai = 0; ai < 2; ++ai)
#pragma unroll
            for (int m = 0; m < 4; ++m) {
                unsigned char* rowp = O + (size_t)(u.pm * 256 + 128 * ai + 64 * wr + 16 * m + fr) * FH + u.pn * 128 + 32 * wc + 8 * fq;
                float h[8];
#pragma unroll
                for (int n = 0; n < 2; ++n) {
                    const f32x4 G = acc[ai][0][m][n], U = acc[ai][1][m][n];
                    const f32x2 g01 = (f32x2){G[0], G[1]}, g23 = (f32x2){G[2], G[3]}, u01 = (f32x2){U[0], U[1]}, u23 = (f32x2){U[2], U[3]};
                    const f32x2 t01 = g01 * (-1.44269504089f), t23 = g23 * (-1.44269504089f);
                    const f32x2 d01 = (f32x2){__builtin_amdgcn_exp2f(t01.x), __builtin_amdgcn_exp2f(t01.y)} * ih + ih;
                    const f32x2 d23 = (f32x2){__builtin_amdgcn_exp2f(t23.x), __builtin_amdgcn_exp2f(t23.y)} * ih + ih;
                    const f32x2 P = d01 * d23;
                    const float r = __builtin_amdgcn_rcpf(P.x * P.y);
                    const f32x2 q = (f32x2){P.y, P.x} * r;
                    const f32x2 h01 = (g01 * u01) * (q * d23), h23 = (g23 * u23) * (q * d01);
                    h[4 * n] = h01.x; h[4 * n + 1] = h01.y; h[4 * n + 2] = h23.x; h[4 * n + 3] = h23.y; }
                u32x2 w; w.x = pk4_fp8(h[0], h[1], h[2], h[3]); w.y = pk4_fp8(h[4], h[5], h[6], h[7]);
                *(u32x2*)rowp = w;
            }
    }
};
constexpr float YS_SCALE = 8.f;
struct EpiYsF8 {
    static constexpr int MSCALE = 0x79797979;
    unsigned char* O;
    __device__ __forceinline__ void operator()(const f32x4 (&acc)[2][2][4][2], const Unit& u, int wr, int wc, int fr_, int fq_) const {
        const int lane_ = otid() & 63, fr = lane_ & 15, fq = lane_ >> 4;
        static_assert(YS_SCALE * 64.f == HID_SCALE * W_SCALE, "MSCALE");
#pragma unroll
        for (int ai = 0; ai < 2; ++ai)
#pragma unroll
            for (int m = 0; m < 4; ++m) {
                unsigned char* rowp = O + (size_t)(u.pm * 256 + 128 * ai + 64 * wr + 16 * m + fr) * D + u.pn * 256 + 32 * wc + 8 * fq;
#pragma unroll
                for (int bj = 0; bj < 2; ++bj) { const f32x4 v0 = acc[ai][bj][m][0], v1 = acc[ai][bj][m][1];
                    u32x2 w; w.x = pk4_fp8(v0[0], v0[1], v0[2], v0[3]); w.y = pk4_fp8(v1[0], v1[1], v1[2], v1[3]);
                    *(u32x2*)(rowp + 128 * bj) = w; }
            }
    }
};
template <bool BASE_BF16>
struct EpiResid {
    static constexpr int MSCALE = 0x76767676;
    const void* base_x; const void* base_c; bf16_t* out; const float* gate  ; const float* scale;
    __device__ __forceinline__ void operator()(const f32x4 (&acc)[2][2][4][2], const Unit& u, int wr, int wc, int fr_, int fq_) const {
        const int lane_ = otid() & 63, fr = lane_ & 15, fq = lane_ >> 4;
        const int modrow = u.pm < 64 ? (u.pm >> 3) : 8;
        const size_t brow0 = u.pm < 64 ? (size_t)u.pm * 256 : (size_t)(u.pm - 64) * 256;
        const void* basep = u.pm < 64 ? base_x : base_c;
        const int colb = u.pn * 256 + 32 * wc + 8 * fq;
        f32x4 g[2][2];
#pragma unroll
        for (int bj = 0; bj < 2; ++bj) { const int col = colb + 128 * bj;
            g[bj][0] = *(const f32x4*)(gate + (size_t)modrow * NADA + col); g[bj][1] = *(const f32x4*)(gate + (size_t)modrow * NADA + col + 4);
            if (scale) { g[bj][0] = g[bj][0] * *(const f32x4*)(scale + col); g[bj][1] = g[bj][1] * *(const f32x4*)(scale + col + 4); } }
#pragma unroll
        for (int ai = 0; ai < 2; ++ai) {
            if constexpr (BASE_BF16) {
                u32x4 bw[4][2];
#pragma unroll
                for (int m = 0; m < 4; ++m)
#pragma unroll
                    for (int bj = 0; bj < 2; ++bj) bw[m][bj] = __builtin_nontemporal_load((const u32x4*)((const bf16_t*)basep + (brow0 + 128 * ai + 64 * wr + 16 * m + fr) * D + colb + 128 * bj));
#pragma unroll
                for (int m = 0; m < 4; ++m)
#pragma unroll
                    for (int bj = 0; bj < 2; ++bj) { const u32x4 w = bw[m][bj]; const int r = 128 * ai + 64 * wr + 16 * m + fr;
                        const f32x2 a0 = unr(w.x), a1 = unr(w.y), a2 = unr(w.z), a3 = unr(w.w);
                        const f32x4 o0 = (f32x4){a0.x, a0.y, a1.x, a1.y} + g[bj][0] * acc[ai][bj][m][0], o1 = (f32x4){a2.x, a2.y, a3.x, a3.y} + g[bj][1] * acc[ai][bj][m][1];
                        u32x4 ow; ow.x = pkr(o0.x, o0.y); ow.y = pkr(o0.z, o0.w); ow.z = pkr(o1.x, o1.y); ow.w = pkr(o1.z, o1.w);
                        *(u32x4*)(out + (size_t)(u.pm * 256 + r) * D + colb + 128 * bj) = ow; }
            } else {
#pragma unroll
                for (int mh = 0; mh < 2; ++mh) {
                    f32x4 bv[2][2][2];
#pragma unroll
                    for (int m2 = 0; m2 < 2; ++m2)
#pragma unroll
                        for (int bj = 0; bj < 2; ++bj) { const float* bp = (const float*)basep + (brow0 + 128 * ai + 64 * wr + 16 * (2 * mh + m2) + fr) * D + colb + 128 * bj;
                            bv[m2][bj][0] = __builtin_nontemporal_load((const f32x4*)bp); bv[m2][bj][1] = __builtin_nontemporal_load((const f32x4*)(bp + 4)); }
#pragma unroll
                    for (int m2 = 0; m2 < 2; ++m2)
#pragma unroll
                        for (int bj = 0; bj < 2; ++bj) { const int m = 2 * mh + m2, r = 128 * ai + 64 * wr + 16 * m + fr;
                            const f32x4 o0 = bv[m2][bj][0] + g[bj][0] * acc[ai][bj][m][0], o1 = bv[m2][bj][1] + g[bj][1] * acc[ai][bj][m][1];
                            u32x4 ow; ow.x = pkr(o0.x, o0.y); ow.y = pkr(o0.z, o0.w); ow.z = pkr(o1.x, o1.y); ow.w = pkr(o1.z, o1.w);
                            *(u32x4*)(out + (size_t)(u.pm * 256 + r) * D + colb + 128 * bj) = ow; }
                    asm volatile("" ::: "memory");
                }
            }
            asm volatile("" ::: "memory");
        }
    }
};
struct EpiInproj {
    bf16_t* P; float* gates; const float* bias;
    __device__ __forceinline__ void operator()(const f32x4 (&acc)[2][2][4][2], const Unit& u, int wr, int wc, int fr_, int fq_) const {
        const int lane_ = otid() & 63, fr = lane_ & 15, fq = lane_ >> 4;
        if (u.pn < 12) {
            const float sc = u.pn < 2 ? 0.125f : 1.f;
#pragma unroll
            for (int ai = 0; ai < 2; ++ai)
#pragma unroll
                for (int m = 0; m < 4; ++m) {
                    bf16_t* rowp = P + (size_t)(u.pm * 256 + 128 * ai + 64 * wr + 16 * m + fr) * NQKVO + u.pn * 256 + 32 * wc + 8 * fq;
#pragma unroll
                    for (int bj = 0; bj < 2; ++bj) { const f32x4 v0 = acc[ai][bj][m][0] * sc, v1 = acc[ai][bj][m][1] * sc;
                        u32x4 w; w.x = pk2(v0[0], v0[1]); w.y = pk2(v0[2], v0[3]); w.z = pk2(v1[0], v1[1]); w.w = pk2(v1[2], v1[3]);
                        *(u32x4*)(rowp + 128 * bj) = w; }
                }
        } else if (wc == 0) {
            const f32x4 b0 = *(const f32x4*)(bias + 8 * fq), b1 = *(const f32x4*)(bias + 8 * fq + 4);
#pragma unroll
            for (int ai = 0; ai < 2; ++ai)
#pragma unroll
                for (int m = 0; m < 4; ++m) {
                    float* rowp = gates + (size_t)(u.pm * 256 + 128 * ai + 64 * wr + 16 * m + fr) * 32 + 8 * fq;
                    *(f32x4*)rowp = acc[ai][0][m][0] + b0; *(f32x4*)(rowp + 4) = acc[ai][0][m][1] + b1;
                }
        }
    }
};

__device__ __forceinline__ int vcu_of_block() { const int G = gridDim.x, bx = blockIdx.x; return (G % 8 == 0) ? (bx % 8) * (G / 8) + bx / 8 : bx; }
struct SchedGrid {
    int nM, nN, G, c, koff_per_pn, pb_per_pn;
    __device__ __forceinline__ bool next(int i, Unit& u) const {
        const int L = i * G + c; if (L >= nM * nN) return false;
        const int nig = 8 * nN, gid = L / nig, fm = gid * 8, gsz = (nM - fm) < 8 ? (nM - fm) : 8, w = L % nig;
        u.pm = fm + (w % gsz); u.pn = w / gsz; u.pb = u.pn * pb_per_pn; u.koff = u.pn * koff_per_pn; return true;
    }
};
struct SchedMoe {
    int nmu, nN, G, c, wbase  ;
    __device__ __forceinline__ bool next(int i, Unit& u) const {
        const int L = i * G + c; if (L >= nmu * nN) return false;
        const int grp = L >> 5, j = L & 31, ngn = nN / 4, mb = grp / ngn, nq = grp % ngn;
        u.pm = mb * 8 + (j & 7); u.pn = nq * 4 + (j >> 3);
        const int e = u.pm < 128 ? (u.pm >> 3) : (u.pm - 128);
        u.pb = wbase + e * nN + u.pn; u.koff = 0; return true;
    }
};

struct SchedInproj {
    static constexpr bool BKOFF = false;
    int G, c;
    __device__ __forceinline__ bool next(int i, Unit& u) const {
        const int L = i * G + c; if (L >= 832 + 56) return false;
        if (L < 832) { const int nig = 8 * 13, gid = L / nig, w = L % nig; u.pm = gid * 8 + (w & 7); u.pn = w >> 3; }
        else { const int idx = L - 832, q = idx % 7; u.pm = 64 + idx / 7; u.pn = q < 6 ? 2 + q : 12; }
        u.pb = u.pn; u.koff = 0; return true;
    }
};
__device__ __forceinline__ void transpose_item(const float* W, int K, int N, bf16_t* WT, int drow0, LAS float* scr, int kb, int nb, int lane) {
    const int k0 = 64 * kb, n0 = 32 * nb;
#pragma unroll 8
    for (int i = 0; i < 32; ++i) { const int kk = 2 * i + (lane >> 5); const int n = n0 + (lane & 31); scr[kk * 33 + (lane & 31)] = (n < N) ? __builtin_nontemporal_load(W + (size_t)(k0 + kk) * N + n) : 0.f; }
    asm volatile("s_waitcnt lgkmcnt(0)" ::: "memory");
    const int cc = lane & 7;
#pragma unroll
    for (int j = 0; j < 4; ++j) { const int n = (lane >> 3) + 8 * j; const LAS float* s = scr + (8 * cc) * 33 + n;
        u32x4 o; o.x = pk2(s[0 * 33], s[1 * 33]); o.y = pk2(s[2 * 33], s[3 * 33]); o.z = pk2(s[4 * 33], s[5 * 33]); o.w = pk2(s[6 * 33], s[7 * 33]);
        *(u32x4*)(WT + (size_t)(drow0 + n) * K + k0 + 8 * cc) = o; }
    asm volatile("s_waitcnt lgkmcnt(0)" ::: "memory");
}

struct F8Item { const float* src; unsigned char* dst; int N, K; };
__device__ __forceinline__ F8Item f8_item(const Params& P, int r, int lane) {
    unsigned char* ws = P.ws;
    const int le = r / 1536, q = r % 1536, kind = q >> 9, idx = q & 511;
    F8Item it;
    if (kind < 2) { const int kb = idx >> 6, nb = idx & 63, n0 = nb * 32; it.N = FH; it.K = D;
        it.src = (kind ? P.w_up : P.w_gate) + (size_t)le * D * FH + (size_t)(128 * kb + (lane >> 3)) * FH + n0 + 4 * (lane & 7);
        it.dst = (unsigned char*)(ws + WS_WGUT) + (size_t)le * 4096 * D + (size_t)((n0 >> 7) * 256 + kind * 128 + (n0 & 127)) * D + 128 * kb; }
    else { const int kb = idx >> 5, nb = idx & 31, n0 = nb * 32; it.N = D; it.K = FH;
        it.src = P.w_down + (size_t)le * FH * D + (size_t)(128 * kb + (lane >> 3)) * D + n0 + 4 * (lane & 7);
        it.dst = (unsigned char*)(ws + WS_WDT) + (size_t)le * D * FH + (size_t)n0 * FH + 128 * kb; }
    return it;
}
__device__ __forceinline__ void f8_load(const F8Item& it, f32x4 (&wv)[16]) {
#pragma unroll
    for (int i = 0; i < 16; ++i) wv[i] = __builtin_nontemporal_load((const f32x4*)(it.src + (size_t)(8 * i) * it.N));
}
template <bool STORE = true>
__device__ __forceinline__ void f8_finish(const F8Item& it, const f32x4 (&wv)[16], LAS float* scr, int lane) {
#pragma unroll
    for (int i = 0; i < 16; ++i) { LAS float* d = scr + (8 * i + (lane >> 3)) * 33 + 4 * (lane & 7); d[0] = wv[i].x; d[1] = wv[i].y; d[2] = wv[i].z; d[3] = wv[i].w; }
    asm volatile("s_waitcnt lgkmcnt(0)" ::: "memory");
    const int cc = lane & 7;
#pragma unroll
    for (int j = 0; j < 4; ++j) { const int n = (lane >> 3) + 8 * j; const LAS float* sp = scr + (16 * cc) * 33 + n;
        u32x4 o;
        o.x = pk4_fp8(sp[0 * 33] * W_SCALE, sp[1 * 33] * W_SCALE, sp[2 * 33] * W_SCALE, sp[3 * 33] * W_SCALE);
        o.y = pk4_fp8(sp[4 * 33] * W_SCALE, sp[5 * 33] * W_SCALE, sp[6 * 33] * W_SCALE, sp[7 * 33] * W_SCALE);
        o.z = pk4_fp8(sp[8 * 33] * W_SCALE, sp[9 * 33] * W_SCALE, sp[10 * 33] * W_SCALE, sp[11 * 33] * W_SCALE);
        o.w = pk4_fp8(sp[12 * 33] * W_SCALE, sp[13 * 33] * W_SCALE, sp[14 * 33] * W_SCALE, sp[15 * 33] * W_SCALE);
        if constexpr (STORE) __builtin_nontemporal_store(o, (u32x4*)(it.dst + (size_t)n * it.K + 16 * cc)); else asm volatile("" :: "v"(o)); }
    asm volatile("s_waitcnt lgkmcnt(0)" ::: "memory");
}

constexpr int F8_L0_ITEMS = NE * 1536, F8_TOTAL = 2 * NE * 1536;
constexpr int F8_N1 = 128 * 8 * 6;
constexpr int F8_N2 = 192 * 8 * 8;
constexpr int F8_N3 = 136 * 8 * 6;
constexpr int F8_N5 = 192 * 8 * 1;
constexpr int F8_N4 = 128 * 8 * 4;
constexpr int F8_DEFERRED = F8_N1 + F8_N2 + F8_N3 + F8_N5 + F8_N4, F8_SKIP = F8_TOTAL - F8_DEFERRED;
constexpr int F8_S1 = F8_SKIP, F8_S2 = F8_S1 + F8_N1, F8_S3 = F8_S2 + F8_N2, F8_S5 = F8_S3 + F8_N3, F8_S4 = F8_S5 + F8_N5;
static_assert(F8_S4 + F8_N4 == F8_TOTAL && F8_S2 >= F8_L0_ITEMS && F8_SKIP > 0, "deferred slices: layer-0 items only in the slice that runs before the layer-0 expert GEMMs");
__device__ __forceinline__ void f8_convert_range(const Params& P, LAS unsigned char* lds, int first, int count, int w, int nworkers, int skip_at, int skip_len) {
    const int tid = otid(), lane = tid & 63, wave = __builtin_amdgcn_readfirstlane(tid >> 6);
    LAS float* scr = (LAS float*)(lds + wave * 17408);
    const int end = first + count; int it = first + w;
    if (it < end) {
        F8Item cur = f8_item(P, it < skip_at ? it : it + skip_len, lane); f32x4 wv[16]; f8_load(cur, wv);
        for (; it < end; it += nworkers) {
            const int nx = it + nworkers; F8Item nxt = cur; f32x4 wn[16];
            if (nx < end) { nxt = f8_item(P, nx < skip_at ? nx : nx + skip_len, lane); f8_load(nxt, wn); }
            f8_finish(cur, wv, scr, lane);
            if (nx < end) {
#pragma unroll
                for (int i = 0; i < 16; ++i) wv[i] = wn[i];
                cur = nxt; }
        }
    }
}

__device__ __forceinline__ void phase0(const Params& P, LAS unsigned char* lds) {
    const int tid = otid(), lane = tid & 63, wave = __builtin_amdgcn_readfirstlane(tid >> 6), G = gridDim.x;
    unsigned char* ws = P.ws;
    {
        LAS float* sv = (LAS float*)lds;
        LAS float* red = sv + 9 * 1024;
        float* mod = (float*)(ws + WS_MOD);
        bool filled = false;
        for (int it = blockIdx.x; it < 192; it += G) {
            if (!filled) {
                { float cv[18];
#pragma unroll
                  for (int q = 0; q < 18; ++q) { const int i = tid + NTHR * q, r = i >> 10, k = i & 1023; cv[q] = r < 8 ? P.c[r * D + k] : P.c_ctx[k]; }
#pragma unroll
                  for (int q = 0; q < 18; ++q) sv[tid + NTHR * q] = siluf(cv[q]); }
                filled = true; __syncthreads();
            }
            const int l = it / 96, n = (it % 96) * 64 + lane;
            const float* w = P.ada_w + (size_t)l * D * NADA + n;
            float a[9];
#pragma unroll
            for (int r = 0; r < 9; ++r) a[r] = 0.f;
#pragma unroll 8
            for (int kk = 0; kk < 128; ++kk) { const int k = wave * 128 + kk; const float wv = __builtin_nontemporal_load(w + (size_t)k * NADA);
#pragma unroll
                for (int r = 0; r < 9; ++r) a[r] += sv[r * 1024 + k] * wv; }
#pragma unroll
            for (int r = 0; r < 9; ++r) red[(wave * 9 + r) * 64 + lane] = a[r];
            __syncthreads();
            for (int i = tid; i < 9 * 64; i += NTHR) { const int r = i >> 6, nn = i & 63; float s = 0.f;
#pragma unroll
                for (int w8 = 0; w8 < 8; ++w8) s += red[(w8 * 9 + r) * 64 + nn];
                const int ncol = (it % 96) * 64 + nn;
                mod[((size_t)l * 9 + r) * NADA + ncol] = s + P.ada_b[l * NADA + ncol]; }
            __syncthreads();
        }
        __syncthreads();
    }
    const int gw = vcu_of_block() * 8 + wave, NGW = G * 8;
    {
        float* rs = (float*)(ws + WS_RSX);
        for (int m = gw; m < NCX; m += NGW) { const f32x4* xr = (const f32x4*)(P.ctx + (size_t)m * D) + lane; float s = 0.f;
#pragma unroll
            for (int j = 0; j < 4; ++j) { const f32x4 v = xr[64 * j]; s += (v.x * v.x + v.y * v.y) + (v.z * v.z + v.w * v.w); }
            s = wave_sum(s); if (lane == 0) rs[NX + m] = rsqrtf(s * (1.f / D) + EPS); }
    }
    {
        u32x4* z = (u32x4*)(ws + WS_WINT + (size_t)NIN * D * 2); const int n16 = (NINP - NIN) * D * 2 / 16;
        for (int i = blockIdx.x * NTHR + tid; i < n16; i += G * NTHR) z[i] = (u32x4){0u, 0u, 0u, 0u};
    }
    {
        LAS float* scr = (LAS float*)(lds + wave * 17408);
        constexpr int I_MOE = 2 * NE * 1536, I_IN = 16 * 97, I_OUT = 8 * 32, I_POOL = 4 * 4 * 8;
        f8_convert_range(P, lds, 0, (G == 256) ? F8_SKIP : F8_TOTAL, gw, NGW, 1 << 30, 0);
        for (int it = gw; it < I_IN + I_OUT + I_POOL; it += NGW) {
            int r = it;
            if (r < I_IN) { const int kb = r / 97, nb = r % 97; transpose_item(P.w_in, D, NIN, (bf16_t*)(ws + WS_WINT), nb * 32, scr, kb, nb, lane); continue; }
            r -= I_IN;
            if (r < I_OUT) { const int kb = r >> 5, nb = r & 31;
                F8Item itw; itw.N = D; itw.K = D; itw.src = P.w_out + (size_t)(128 * kb + (lane >> 3)) * D + nb * 32 + 4 * (lane & 7); itw.dst = (unsigned char*)(ws + WS_WOUTT) + (size_t)(nb * 32) * D + 128 * kb;
                f32x4 wv[16]; f8_load(itw, wv); f8_finish(itw, wv, scr, lane); continue; }
            r -= I_OUT;
            { const int j = r >> 5, q = r & 31, kb = q >> 3, nb = q & 7; transpose_item(P.pool_w + (size_t)j * 256 * 256, 256, 256, (bf16_t*)(ws + WS_POOLWT) + (size_t)j * 256 * 256, nb * 32, scr, kb, nb, lane); }
        }
    }
}


#ifndef PROBE_P0R
#define PROBE_P0R 0
#endif
__device__ __forceinline__ void probe_p0_readonly(const Params& P, LAS unsigned char* lds) {
    const int tid = otid(), lane = tid & 63, wave = __builtin_amdgcn_readfirstlane(tid >> 6), G = gridDim.x;
    const int gw = vcu_of_block() * 8 + wave, NGW = G * 8;
    LAS float* scr = (LAS float*)(lds + wave * 17408);
    constexpr int I_MOE = 2 * NE * 1536;
    if (gw < I_MOE) {
        F8Item cur = f8_item(P, gw, lane); f32x4 wv[16]; f8_load(cur, wv);
        for (int it = gw; it < I_MOE; it += NGW) {
            const int nx = it + NGW; F8Item nxt = cur; f32x4 wn[16];
            if (nx < I_MOE) { nxt = f8_item(P, nx, lane); f8_load(nxt, wn); }
            f8_finish<false>(cur, wv, scr, lane);
            if (nx < I_MOE) {
#pragma unroll
                for (int i = 0; i < 16; ++i) wv[i] = wn[i];
                cur = nxt; }
        }
    }
}
template <int W>
__device__ __forceinline__ void hslide64(const f32x2 (&z)[64], bf16_t* outp  ) {
    constexpr int HW = W / 2;
    f32x2 s = (f32x2){0.f, 0.f};
#pragma unroll
    for (int c = 0; c < HW; ++c) s += z[c];
#pragma unroll
    for (int c = 0; c < 64; ++c) {
        const int lo = c - HW < 0 ? 0 : c - HW, hi = c + HW > 64 ? 64 : c + HW;
        const float inv = 1.f / (float)(hi - lo);
        { const f32x2 hm = s * inv; *(unsigned*)(outp + (size_t)c * D) = pk2(hm.x, hm.y); }
        if (c + HW < 64) s += z[c + HW];
        if (c - HW >= 0) s -= z[c - HW];
    }
}
template <int W>
__device__ __forceinline__ void cslide32(const f32x2 (&zc)[48], int t0, f32x2 Gc, bf16_t* ap  ) {
    constexpr int HW = W / 2;
    f32x2 s = (f32x2){0.f, 0.f};
#pragma unroll
    for (int i = 8 - HW; i < 8 + HW; ++i) s += zc[i];
#pragma unroll
    for (int k = 0; k < 32; ++k) {
        const int t = t0 + k, lo = t - HW < 0 ? 0 : t - HW, hi = t + HW > TC ? TC : t + HW;
        const f32x2 df = (s * (1.f / (float)(hi - lo)) - zc[8 + k]) * Gc;
        *(unsigned*)(ap + (size_t)k * D) = pk2(df.x, df.y);
        s += zc[8 + k + HW]; s -= zc[8 + k - HW];
    }
}
__device__ __forceinline__ void phase1(const Params& P, LAS unsigned char* lds) {
    const int tid = otid(), lane = tid & 63, wave = __builtin_amdgcn_readfirstlane(tid >> 6), G = gridDim.x;
    unsigned char* ws = P.ws;
    float* rs = (float*)(ws + WS_RSX); bf16_t* Hb = (bf16_t*)(ws + WS_BIG);
    LAS float* red = (LAS float*)lds;
    LAS float* rr = red + 512;
    const int d0 = 2 * tid, grp = tid >> 7;
    for (int it = blockIdx.x; it < NB * 32; it += G) {
        const int tok0 = it * 64;
        const float* xp = P.x + (size_t)tok0 * D + d0;
        f32x2 z[64]; float ss[64];
#pragma unroll
        for (int c = 0; c < 64; ++c) { z[c] = *(const f32x2*)(xp + (size_t)c * D); ss[c] = z[c].x * z[c].x + z[c].y * z[c].y; }
        { bf16_t* xh = (bf16_t*)(ws + WS_XB) + (size_t)tok0 * D + d0;
#pragma unroll
          for (int c = 0; c < 64; ++c) *(unsigned*)(xh + (size_t)c * D) = pkr(z[c].x, z[c].y); }
#pragma unroll
        for (int off = 32; off >= 1; off >>= 1) {
            const bool up = (lane & off) != 0;
#pragma unroll
            for (int i = 0; i < off; ++i) { const float keep = up ? ss[i + off] : ss[i], send = up ? ss[i] : ss[i + off]; ss[i] = keep + __shfl_xor(send, off); }
        }
        red[wave * 64 + lane] = ss[0];
        __syncthreads();
        if (tid < 64) { float s = 0.f;
#pragma unroll
            for (int w8 = 0; w8 < 8; ++w8) s += red[w8 * 64 + tid];
            const float r = rsqrtf(s * (1.f / D) + EPS); rr[tid] = r; rs[tok0 + tid] = r; }
        __syncthreads();
#pragma unroll
        for (int c = 0; c < 64; ++c) z[c] = z[c] * rr[c];
        bf16_t* outp = Hb + (size_t)tok0 * D + d0;
        switch (grp) { case 0: hslide64<2>(z, outp); break; case 1: hslide64<4>(z, outp); break; case 2: hslide64<8>(z, outp); break; default: hslide64<16>(z, outp); break; }
        __syncthreads();
    }
}
__device__ __forceinline__ void ctx_pool(const Params& P) {
    const int tid = otid(); unsigned char* ws = P.ws; const float* rs = (const float*)(ws + WS_RSX); const int d0 = 2 * tid, grp = tid >> 7;
    if (blockIdx.x < 64) {
        const float* mod0 = (const float*)(ws + WS_MOD) + (size_t)8 * NADA;
        bf16_t* A = (bf16_t*)(ws + WS_ABF);
        const f32x2 nm = *(const f32x2*)(P.norm_mix + d0), sc = *(const f32x2*)(mod0 + D + d0);
        const f32x2 Gc = nm * (sc + 1.f);
        const int it = blockIdx.x, b = it >> 3, t0 = (it & 7) * 32;
        f32x2 zc[48];
#pragma unroll
        for (int i = 0; i < 48; ++i) { const int t = t0 - 8 + i; const bool ok = (t >= 0 && t < TC); const int tt = ok ? t : t0;
            const f32x2 xv = *(const f32x2*)(P.ctx + (size_t)(b * TC + tt) * D + d0); const float rv = rs[NX + b * TC + tt];
            zc[i] = ok ? xv * rv : (f32x2){0.f, 0.f}; }
        bf16_t* ap = A + (size_t)(NX + b * TC + t0) * D + d0;
        switch (grp) { case 0: cslide32<2>(zc, t0, Gc, ap); break; case 1: cslide32<4>(zc, t0, Gc, ap); break; case 2: cslide32<8>(zc, t0, Gc, ap); break; default: cslide32<16>(zc, t0, Gc, ap); break; }
    }
}

__device__ __forceinline__ void pool_ctx_subtiles(const Params& P, bf16_t* XA16) {
    const int tid = otid(), lane = tid & 63, wave = __builtin_amdgcn_readfirstlane(tid >> 6), fr = lane & 15, fq = lane >> 4;
    unsigned char* ws = P.ws;
    const bf16_t* A = (const bf16_t*)(ws + WS_ABF); const bf16_t* Wt = (const bf16_t*)(ws + WS_POOLWT);
    const float* gate = (const float*)(ws + WS_MOD) + (size_t)8 * NADA + 2 * D;
    for (int su = vcu_of_block(); su < 256; su += gridDim.x) {
        const int rb = su >> 2, j = su & 3;
        bf16x8 Af[2][8], Bf[2][8];
#pragma unroll
        for (int rt = 0; rt < 2; ++rt)
#pragma unroll
            for (int ks = 0; ks < 8; ++ks) Af[rt][ks] = *(const bf16x8*)(A + (size_t)(NX + 32 * rb + 16 * rt + fr) * D + 256 * j + 32 * ks + 8 * fq);
#pragma unroll
        for (int nt = 0; nt < 2; ++nt)
#pragma unroll
            for (int ks = 0; ks < 8; ++ks) Bf[nt][ks] = *(const bf16x8*)(Wt + (size_t)(j * 256 + 32 * wave + 16 * nt + fr) * 256 + 32 * ks + 8 * fq);
        f32x4 acc[2][2];
#pragma unroll
        for (int rt = 0; rt < 2; ++rt)
#pragma unroll
            for (int nt = 0; nt < 2; ++nt) { acc[rt][nt] = (f32x4){0.f, 0.f, 0.f, 0.f};
#pragma unroll
                for (int ks = 0; ks < 8; ++ks) acc[rt][nt] = __builtin_amdgcn_mfma_f32_16x16x32_bf16(Bf[nt][ks], Af[rt][ks], acc[rt][nt], 0, 0, 0); }
#pragma unroll
        for (int nt = 0; nt < 2; ++nt) { const int col = 256 * j + 32 * wave + 16 * nt + 4 * fq;
            const f32x4 gv = *(const f32x4*)(gate + col) * *(const f32x4*)(P.pool_scale + col);
#pragma unroll
            for (int rt = 0; rt < 2; ++rt) { const int r = 32 * rb + 16 * rt + fr;
                const f32x4 o = *(const f32x4*)(P.ctx + (size_t)r * D + col) + gv * acc[rt][nt];
                u32x2 w; w.x = pkr(o.x, o.y); w.y = pkr(o.z, o.w);
                *(u32x2*)(XA16 + (size_t)(NX + r) * D + col) = w; } }
    }
}

template <int W>
__device__ __forceinline__ void vslide32(const f32x2 (&hv)[32], const f32x2 (&zv)[32], f32x2 Gm, bf16_t* acol) {
    constexpr int HW = W / 2;
    f32x2 s = (f32x2){0.f, 0.f};
#pragma unroll
    for (int r = 0; r < HW; ++r) s += hv[r];
#pragma unroll
    for (int r = 0; r < 32; ++r) {
        const int lo = r - HW < 0 ? 0 : r - HW, hi = r + HW > 32 ? 32 : r + HW;
        const float inv = 1.f / (float)(hi - lo);
        const f32x2 df = (s * inv - zv[r]) * Gm;
        *(unsigned*)(acol + (size_t)r * 64 * D) = pk2(df.x, df.y);
        if (r + HW < 32) s += hv[r + HW];
        if (r - HW >= 0) s -= hv[r - HW];
    }
}
__device__ __forceinline__ void phase2(const Params& P, LAS unsigned char* lds) {
    const int tid = otid(), G = gridDim.x;
    unsigned char* ws = P.ws;
    const float* rs = (const float*)(ws + WS_RSX); const bf16_t* Hb = (const bf16_t*)(ws + WS_BIG); bf16_t* A = (bf16_t*)(ws + WS_ABF);
    const int d0 = 2 * tid, grp = tid >> 7;
    const f32x2 nm = *(const f32x2*)(P.norm_mix + d0);
    for (int it = blockIdx.x; it < NB * 64; it += G) {
        const int b = it >> 6, c = it & 63, tok0 = b * T + c;
        const f32x2 sc = *(const f32x2*)((const float*)(ws + WS_MOD) + (size_t)b * NADA + D + d0);
        const f32x2 Gm = nm * (sc + 1.f);
        f32x2 hv[32];
#pragma unroll
        for (int r = 0; r < 32; ++r) { const unsigned w = __builtin_nontemporal_load((const unsigned*)(Hb + (size_t)(tok0 + r * 64) * D + d0)); hv[r] = (f32x2){__builtin_bit_cast(float, w << 16), __builtin_bit_cast(float, w & 0xffff0000u)}; }
        const bf16_t* xcol = (const bf16_t*)(ws + WS_XB) + (size_t)tok0 * D + d0; bf16_t* acol = A + (size_t)tok0 * D + d0; const float* rsc = rs + tok0;
        f32x2 zv[32];
#pragma unroll
        for (int r = 0; r < 32; ++r) zv[r] = unr(*(const unsigned*)(xcol + (size_t)r * 64 * D)) * rsc[r * 64];
        switch (grp) { case 0: vslide32<2>(hv, zv, Gm, acol); break; case 1: vslide32<4>(hv, zv, Gm, acol); break; case 2: vslide32<8>(hv, zv, Gm, acol); break; default: vslide32<16>(hv, zv, Gm, acol); break; }
    }
}

constexpr int WTP = 1028;
template <bool ROUTER, bool OUTF8>
__device__ __forceinline__ void norm_rows(LAS unsigned char* lds, const float* xin, int nrows, const float* g, const float* modl  , int sh_chunk, bf16_t* A, const float* router  , float* aff) {
    const int tid = otid(), lane = tid & 63, wave = __builtin_amdgcn_readfirstlane(tid >> 6);
    const int gw = vcu_of_block() * 8 + wave, NGW = gridDim.x * 8;
    LAS float* wT = (LAS float*)lds;
    if constexpr (ROUTER) {
        float wt[32];
#pragma unroll
        for (int i = 0; i < 32; ++i) wt[i] = router[tid + NTHR * i];
#pragma unroll
        for (int i = 0; i < 32; ++i) { const int k = tid + NTHR * i; wT[(k & 15) * WTP + (k >> 4)] = wt[i]; }
        __syncthreads();
    }
    const int per = (nrows + NGW - 1) / NGW, mbeg = gw * per, mend = (mbeg + per < nrows) ? mbeg + per : nrows;
    f32x4 xn[4], gs[4], sh4[4]; int curmod = -1;
    if (mbeg < mend) { const f32x4* xr = (const f32x4*)(xin + (size_t)mbeg * D) + lane;
#pragma unroll
        for (int j = 0; j < 4; ++j) xn[j] = xr[64 * j]; }
    for (int m = mbeg; m < mend; ++m) {
        const int modrow = m < NX ? m / T : 8;
        f32x4 v[4]; float s = 0.f;
#pragma unroll
        for (int j = 0; j < 4; ++j) { v[j] = xn[j]; s += (v[j].x * v[j].x + v[j].y * v[j].y) + (v[j].z * v[j].z + v[j].w * v[j].w); }
        if (m + 1 < mend) { const f32x4* xr = (const f32x4*)(xin + (size_t)(m + 1) * D) + lane;
#pragma unroll
            for (int j = 0; j < 4; ++j) xn[j] = xr[64 * j]; }
        if (modrow != curmod) { curmod = modrow; const float* shp = modl + (size_t)modrow * NADA + sh_chunk * D; const float* scp = shp + D;
#pragma unroll
            for (int j = 0; j < 4; ++j) { const int e = 4 * lane + 256 * j; gs[j] = *(const f32x4*)(g + e) * (*(const f32x4*)(scp + e) + 1.f); sh4[j] = *(const f32x4*)(shp + e); } }
        const float r = rsqrtf(wave_sum(s) * (1.f / D) + EPS);
#pragma unroll
        for (int j = 0; j < 4; ++j) { const int e = 4 * lane + 256 * j;
            v[j] = v[j] * r * gs[j] + sh4[j];
            if constexpr (OUTF8) *(unsigned*)((unsigned char*)A + (size_t)m * D + e) = pk4_fp8(v[j].x * ACT_SCALE, v[j].y * ACT_SCALE, v[j].z * ACT_SCALE, v[j].w * ACT_SCALE);
            else { u32x2 w; w.x = pk2(v[j].x, v[j].y); w.y = pk2(v[j].z, v[j].w); *(u32x2*)(A + (size_t)m * D + e) = w; } }
        if constexpr (ROUTER) {
            float lg[16];
#pragma unroll
            for (int e = 0; e < 16; ++e) { float a = 0.f;
#pragma unroll
                for (int j = 0; j < 4; ++j) { const f32x4 wv = *(const LAS f32x4*)(wT + e * WTP + 4 * lane + 256 * j); a += (v[j].x * wv.x + v[j].y * wv.y) + (v[j].z * wv.z + v[j].w * wv.w); }
                lg[e] = a;
                if ((e & 3) == 3) asm volatile("" ::: "memory"); }
#pragma unroll
            for (int st = 0; st < 4; ++st) { const int off = 32 >> st, cnt = 8 >> st; const bool up = (lane & off) != 0;
#pragma unroll
                for (int i = 0; i < cnt; ++i) { const float keep = up ? lg[i + cnt] : lg[i], send = up ? lg[i] : lg[i + cnt]; lg[i] = keep + __shfl_xor(send, off); } }
            float l0 = lg[0]; l0 += __shfl_xor(l0, 2); l0 += __shfl_xor(l0, 1);
            float mx = l0;
#pragma unroll
            for (int off = 4; off < 64; off <<= 1) mx = fmaxf(mx, __shfl_xor(mx, off));
            const float ex = __expf(l0 - mx); float den = ex;
#pragma unroll
            for (int off = 4; off < 64; off <<= 1) den += __shfl_xor(den, off);
            const int l2 = otid() & 63;
            if ((l2 & 3) == 0) aff[(size_t)m * NE + (l2 >> 2)] = ex / den;
        }
    }
    if constexpr (ROUTER) __syncthreads();
}

__device__ __forceinline__ void norm_router_mfma(LAS unsigned char* lds, const bf16_t* xin  , int nrows, const float* g, const float* modl  , int sh_chunk, unsigned char* A8, const float* router  , float* aff) {
    const int tid = otid(), lane = tid & 63, wave = __builtin_amdgcn_readfirstlane(tid >> 6), t = lane & 15, q = lane >> 4;
    const int vc = vcu_of_block(), gw = vc * 8 + wave, NGW = gridDim.x * 8;
    LAS float* wT = (LAS float*)lds;
    LAS float* gT = wT + 16 * WTP;
    LAS float* hT = gT + 2048;
    const int per = (nrows + NGW - 1) / NGW;
    const int blk_first = vc * 8 * per, blk_last = (blk_first + 8 * per - 1 < nrows - 1) ? blk_first + 8 * per - 1 : nrows - 1;
    const int mod_lo = blk_first < NX ? blk_first / T : 8;
    {
        float wt[32];
#pragma unroll
        for (int i = 0; i < 32; ++i) wt[i] = router[tid + NTHR * i];
#pragma unroll
        for (int i = 0; i < 32; ++i) { const int k = tid + NTHR * i; wT[(k & 15) * WTP + (k >> 4)] = wt[i]; }
        if (blk_first < nrows) {
            const int mi = tid >> 8, c4 = (tid & 255) * 4; int mr = mod_lo + mi; if (mr > 8) mr = 8;
            const float* shp = modl + (size_t)mr * NADA + sh_chunk * D;
            const f32x4 gg = *(const f32x4*)(g + c4), sc = *(const f32x4*)(shp + D + c4), hh = *(const f32x4*)(shp + c4);
            *(LAS f32x4*)(gT + mi * 1024 + c4) = gg * (sc + 1.f); *(LAS f32x4*)(hT + mi * 1024 + c4) = hh;
        }
        __syncthreads();
    }
    const int mbeg = gw * per, mend = (mbeg + per < nrows) ? mbeg + per : nrows;
    for (int m0 = mbeg; m0 < mend; m0 += 16) {
        const int nr = (mend - m0) < 16 ? (mend - m0) : 16;
        const bool ok = t < nr; const int m = ok ? m0 + t : m0;
        const int modrow = m < NX ? m / T : 8, mi = (modrow != mod_lo) ? 1 : 0;
        const bf16_t* xr = xin + (size_t)m * D + 8 * q;
        float ss = 0.f;
#pragma unroll 8
        for (int s = 0; s < 32; ++s) { const u32x4 w = *(const u32x4*)(xr + 32 * s);
            const f32x2 p0 = unr(w.x), p1 = unr(w.y), p2 = unr(w.z), p3 = unr(w.w);
            ss += (p0.x * p0.x + p0.y * p0.y) + (p1.x * p1.x + p1.y * p1.y) + (p2.x * p2.x + p2.y * p2.y) + (p3.x * p3.x + p3.y * p3.y); }
        ss += __shfl_xor(ss, 16); ss += __shfl_xor(ss, 32);
        const float r = rsqrtf(ss * (1.f / D) + EPS);
        unsigned char* ap = A8 + (size_t)m * D + 8 * q;
        const LAS float* wp = wT + t * WTP + 8 * q;
        const LAS float* gp = gT + mi * 1024 + 8 * q; const LAS float* hp = hT + mi * 1024 + 8 * q;
        f32x4 accA = (f32x4){0.f, 0.f, 0.f, 0.f}, accB = (f32x4){0.f, 0.f, 0.f, 0.f};
        u32x4 xb[4];
#pragma unroll
        for (int i = 0; i < 4; ++i) xb[i] = *(const u32x4*)(xr + 32 * i);
#pragma unroll 1
        for (int s4 = 0; s4 < 8; ++s4) {
#pragma unroll
            for (int i = 0; i < 4; ++i) {
                const int s = 4 * s4 + i; const u32x4 xw = xb[i];
                if (s4 < 7) xb[i] = *(const u32x4*)(xr + 32 * (s + 4));
                const f32x2 q0 = unr(xw.x), q1 = unr(xw.y), q2 = unr(xw.z), q3 = unr(xw.w);
                const f32x4 g0 = *(const LAS f32x4*)(gp + 32 * s), g1 = *(const LAS f32x4*)(gp + 32 * s + 4), h0 = *(const LAS f32x4*)(hp + 32 * s), h1 = *(const LAS f32x4*)(hp + 32 * s + 4);
                const f32x4 w0 = *(const LAS f32x4*)(wp + 32 * s), w1 = *(const LAS f32x4*)(wp + 32 * s + 4);
                const f32x4 v0 = (f32x4){q0.x, q0.y, q1.x, q1.y} * r * g0 + h0, v1 = (f32x4){q2.x, q2.y, q3.x, q3.y} * r * g1 + h1;
                if (ok) { u32x2 w; w.x = pk4_fp8(v0.x * ACT_SCALE, v0.y * ACT_SCALE, v0.z * ACT_SCALE, v0.w * ACT_SCALE); w.y = pk4_fp8(v1.x * ACT_SCALE, v1.y * ACT_SCALE, v1.z * ACT_SCALE, v1.w * ACT_SCALE);
                    *(u32x2*)(ap + 32 * s) = w; }
                accA = __builtin_amdgcn_mfma_f32_16x16x4f32(w0.x, v0.x, accA, 0, 0, 0); accB = __builtin_amdgcn_mfma_f32_16x16x4f32(w1.x, v1.x, accB, 0, 0, 0);
                accA = __builtin_amdgcn_mfma_f32_16x16x4f32(w0.y, v0.y, accA, 0, 0, 0); accB = __builtin_amdgcn_mfma_f32_16x16x4f32(w1.y, v1.y, accB, 0, 0, 0);
                accA = __builtin_amdgcn_mfma_f32_16x16x4f32(w0.z, v0.z, accA, 0, 0, 0); accB = __builtin_amdgcn_mfma_f32_16x16x4f32(w1.z, v1.z, accB, 0, 0, 0);
                accA = __builtin_amdgcn_mfma_f32_16x16x4f32(w0.w, v0.w, accA, 0, 0, 0); accB = __builtin_amdgcn_mfma_f32_16x16x4f32(w1.w, v1.w, accB, 0, 0, 0);
            }
        }
        const f32x4 acc = accA + accB;
        float mx = fmaxf(fmaxf(acc.x, acc.y), fmaxf(acc.z, acc.w));
        mx = fmaxf(mx, __shfl_xor(mx, 16)); mx = fmaxf(mx, __shfl_xor(mx, 32));
        const f32x4 ex = (f32x4){__expf(acc.x - mx), __expf(acc.y - mx), __expf(acc.z - mx), __expf(acc.w - mx)};
        float den = (ex.x + ex.y) + (ex.z + ex.w);
        den += __shfl_xor(den, 16); den += __shfl_xor(den, 32);
        if (ok) *(f32x4*)(aff + (size_t)m * NE + 4 * q) = (f32x4){ex.x / den, ex.y / den, ex.z / den, ex.w / den};
    }
    __syncthreads();
}

__device__ __forceinline__ void topk_item(LAS unsigned long long* keys, const float* aff_re  , int N, int cap, int* pos_re  , int* rowtab_slot, int rowbase) {
    const int tid = otid(), lane = tid & 63, wave = tid >> 6;
    { float av[4];
#pragma unroll
      for (int q = 0; q < 4; ++q) { const int i = tid + NTHR * q; av[q] = i < N ? aff_re[(size_t)i * NE] : 0.f; }
#pragma unroll
      for (int q = 0; q < 4; ++q) { const int i = tid + NTHR * q; if (i < N) keys[i] = ((unsigned long long)(~__builtin_bit_cast(unsigned, av[q])) << 32) | (unsigned)i; } }
    __syncthreads();
    const bool active = wave * 256 < N;
    for (int k = 2; k <= N; k <<= 1)
        for (int j = k >> 1; j > 0; j >>= 1) {
            if (j >= 256) {
                for (int c = tid; c < N / 2; c += NTHR) {
                    const int i = 2 * c - (c & (j - 1)), l = i + j;
                    const bool up = (i & k) == 0;
                    const unsigned long long a = keys[i], b = keys[l];
                    if ((a > b) == up) { keys[i] = b; keys[l] = a; }
                }
                __syncthreads();
            } else if (active) {
#pragma unroll
                for (int cc = 0; cc < 2; ++cc) {
                    const int c = wave * 128 + cc * 64 + lane;
                    const int i = 2 * c - (c & (j - 1)), l = i + j;
                    const bool up = (i & k) == 0;
                    const unsigned long long a = keys[i], b = keys[l];
                    if ((a > b) == up) { keys[i] = b; keys[l] = a; }
                }
                asm volatile("s_waitcnt lgkmcnt(0)" ::: "memory");
            }
            if (j == 1) __syncthreads();
        }
    for (int p = tid; p < N; p += NTHR) { const int tok = (int)(unsigned)keys[p]; pos_re[(size_t)tok * NE] = p; if (p < cap) rowtab_slot[p] = rowbase + tok; }
    __syncthreads();
}
__device__ __forceinline__ void phase_topk(const Params& P, LAS unsigned char* lds, bool with_ctx) {
    unsigned char* ws = P.ws;
    LAS unsigned long long* keys = (LAS unsigned long long*)lds;
    const int nitems = with_ctx ? 256 : 128;
    int* rowtab = (int*)(ws + WS_ROWTAB); const float* aff = (const float*)(ws + WS_AFF); int* pos = (int*)(ws + WS_POS);
    for (int it = blockIdx.x; it < nitems; it += gridDim.x) {
        const int be = it >> (with_ctx ? 1 : 0); const bool isc = with_ctx && (it & 1);
        const int b = be >> 4, e = be & 15;
        if (!isc) topk_item(keys, aff + (size_t)(b * T) * NE + e, T, CAPX, pos + (size_t)(b * T) * NE + e, rowtab + (e * 8 + b) * 256, b * T);
        else topk_item(keys, aff + (size_t)(NX + b * TC) * NE + e, TC, CAPC, pos + (size_t)(NX + b * TC) * NE + e, rowtab + (128 + e) * 256 + b * 32, NX + b * TC);
    }
    const int wave = __builtin_amdgcn_readfirstlane(otid() >> 6);
    if (gridDim.x == 256) {
        if (with_ctx) { if (blockIdx.x & 1) f8_convert_range(P, lds, F8_S1, F8_N1, (blockIdx.x >> 1) * 8 + wave, 128 * 8, 1 << 30, 0); }
        else if (blockIdx.x >= 128) f8_convert_range(P, lds, F8_S4, F8_N4, (blockIdx.x - 128) * 8 + wave, 128 * 8, 1 << 30, 0);
    }
}

__device__ __forceinline__ void combine_rows(const Params& P, const bf16_t* xin, bf16_t* xout, int nrows, const float* modl,
                                             const float* gnext, const float* modnext  , bf16_t* A, float* fout, const float* gfinal) {
    unsigned char* ws = P.ws;
    const int tid = otid(), lane = tid & 63, wave = __builtin_amdgcn_readfirstlane(tid >> 6);
    const int gw = vcu_of_block() * 8 + wave, NGW = gridDim.x * 8;
    const unsigned char* ys = (const unsigned char*)(ws + WS_YS);
    const int* pos = (const int*)(ws + WS_POS); const float* aff = (const float*)(ws + WS_AFF);
    const int l16 = lane & 15;
    const int per = (nrows + NGW - 1) / NGW, mbeg = gw * per, mend = (mbeg + per < nrows) ? mbeg + per : nrows;
    u32x2 xn[4]; f32x4 gt[4], gs[4], sh4[4]; int pn = 0; float an = 0.f; int curmod = -1;
    if (mbeg < mend) { const u32x2* xr = (const u32x2*)(xin + (size_t)mbeg * D) + lane;
#pragma unroll
        for (int j = 0; j < 4; ++j) xn[j] = __builtin_nontemporal_load(xr + 64 * j);
        pn = pos[(size_t)mbeg * NE + l16]; an = aff[(size_t)mbeg * NE + l16]; }
    for (int m = mbeg; m < mend; ++m) {
        f32x4 v[4];
#pragma unroll
        for (int j = 0; j < 4; ++j) { const f32x2 c0 = unr(xn[j].x), c1 = unr(xn[j].y); v[j] = (f32x4){c0.x, c0.y, c1.x, c1.y}; }
        const int pc = pn; const float ac = an;
        if (m + 1 < mend) { const u32x2* xr = (const u32x2*)(xin + (size_t)(m + 1) * D) + lane;
#pragma unroll
            for (int j = 0; j < 4; ++j) xn[j] = __builtin_nontemporal_load(xr + 64 * j);
            pn = pos[(size_t)(m + 1) * NE + l16]; an = aff[(size_t)(m + 1) * NE + l16]; }
        const bool isx = m < NX; const int b = isx ? m / T : (m - NX) / TC, modrow = isx ? b : 8, cap = isx ? CAPX : CAPC;
        if (modrow != curmod) { curmod = modrow; const float* gp = modl + (size_t)modrow * NADA + 5 * D;
#pragma unroll
            for (int j = 0; j < 4; ++j) { const int e = 4 * lane + 256 * j; gt[j] = *(const f32x4*)(gp + e);
                if (modnext) { const float* shp = modnext + (size_t)modrow * NADA; gs[j] = *(const f32x4*)(gnext + e) * (*(const f32x4*)(shp + D + e) + 1.f); sh4[j] = *(const f32x4*)(shp + e); }
                else { gs[j] = *(const f32x4*)(gfinal + e); sh4[j] = (f32x4){0.f, 0.f, 0.f, 0.f}; } } }
        unsigned long long mask = __ballot(pc < cap) & 0xffffull;
        f32x4 a[4];
#pragma unroll
        for (int j = 0; j < 4; ++j) a[j] = (f32x4){0.f, 0.f, 0.f, 0.f};
        while (mask) {
            const int e = __builtin_ctzll(mask); mask &= mask - 1;
            const int pe = __builtin_amdgcn_readlane(pc, e); const float af = __builtin_bit_cast(float, __builtin_amdgcn_readlane(__builtin_bit_cast(int, ac), e)) * (1.f / YS_SCALE);
            const size_t yrow = isx ? (size_t)(e * 8 + b) * 256 + pe : (size_t)(128 + e) * 256 + b * 32 + pe;
            const unsigned char* yr = ys + yrow * D + 4 * lane;
#pragma unroll
            for (int j = 0; j < 4; ++j) { const unsigned w = *(const unsigned*)(yr + 256 * j);
                const f32x2 lo = __builtin_amdgcn_cvt_pk_f32_fp8(w, false), hi = __builtin_amdgcn_cvt_pk_f32_fp8(w, true);
                a[j].x += af * lo.x; a[j].y += af * lo.y; a[j].z += af * hi.x; a[j].w += af * hi.y; }
        }
        float s = 0.f;
#pragma unroll
        for (int j = 0; j < 4; ++j) { v[j] = v[j] + gt[j] * a[j]; s += (v[j].x * v[j].x + v[j].y * v[j].y) + (v[j].z * v[j].z + v[j].w * v[j].w); }
        const float r = rsqrtf(wave_sum(s) * (1.f / D) + EPS);
        if (modnext) {
#pragma unroll
            for (int j = 0; j < 4; ++j) { const int e = 4 * lane + 256 * j;
                { u32x2 xw; xw.x = pkr(v[j].x, v[j].y); xw.y = pkr(v[j].z, v[j].w); *(u32x2*)(xout + (size_t)m * D + e) = xw; }
                const f32x4 hv = v[j] * r * gs[j] + sh4[j];
                u32x2 w; w.x = pk2(hv.x, hv.y); w.y = pk2(hv.z, hv.w); *(u32x2*)(A + (size_t)m * D + e) = w; }
        } else {
#pragma unroll
            for (int j = 0; j < 4; ++j) { const int e = 4 * lane + 256 * j; __builtin_nontemporal_store(v[j] * r * gs[j], (f32x4*)(fout + (size_t)m * D + e)); }
        }
    }
}

constexpr int TP = 264;
typedef short s16x4 __attribute__((ext_vector_type(4)));
__device__ __forceinline__ void mlstm_m1(const Params& P, LAS unsigned char* lds) {
    const int tid = otid(), lane = tid & 63, wave = __builtin_amdgcn_readfirstlane(tid >> 6), G = gridDim.x, fr = lane & 15, fq = lane >> 4;
    unsigned char* ws = P.ws;
    const bf16_t* pb = (const bf16_t*)(ws + WS_BIG); const float* gates = (const float*)(ws + WS_GATES);
    constexpr int VP = 144, KP = 72;
    LAS bf16_t* Vs = (LAS bf16_t*)lds;
    LAS bf16_t* Ks = Vs + 256 * VP;
    LAS float* fa = (LAS float*)(Ks + 256 * KP);
    LAS float* sF = fa; LAS float* sB = fa + 512; LAS float* esF = fa + 1024; LAS float* esB = fa + 1280; LAS float* mxs = fa + 1536; LAS float* red = fa + 2048;
    const int trq = (lane & 15) >> 2, trp = lane & 3;
    for (int it = blockIdx.x; it < NB * NH * 9; it += G) {
        const int ch = it % 9, bh = it / 9, h = bh & 7, b = bh >> 3;
        const int row0 = ch == 0 ? NX + b * TC : b * T + (ch - 1) * 256;
        float* gb = (float*)(ws + WS_GBUF) + (size_t)it * GB_STRIDE;
        u32x4 kreg[4], vreg[8];
#pragma unroll
        for (int i = 0; i < 4; ++i) { const int piece = tid + NTHR * i, sr = piece >> 3, seg = piece & 7; kreg[i] = *(const u32x4*)(pb + (size_t)(row0 + sr) * NQKVO + 512 + h * 64 + seg * 8); }
#pragma unroll
        for (int i = 0; i < 8; ++i) { const int piece = tid + NTHR * i, sr = piece >> 4, seg = piece & 15; vreg[i] = *(const u32x4*)(pb + (size_t)(row0 + sr) * NQKVO + 1024 + h * 128 + seg * 8); }
        float giF = 0.f, giB = 0.f;
        if (tid < 256) {
            const float* gr = gates + (size_t)(row0 + tid) * 32 + h;
            giF = gr[0]; giB = gr[16];
            sF[tid] = logsigmoidf(gr[8]); sB[255 - tid] = logsigmoidf(gr[24]);
        }
#pragma unroll
        for (int i = 0; i < 8; ++i) { const int piece = tid + NTHR * i, sr = piece >> 4, seg = piece & 15; *(LAS u32x4*)(Vs + sr * VP + seg * 8) = vreg[i]; }
        __syncthreads();
        int cur = 0;
        for (int off = 1; off < 256; off <<= 1) {
            if (tid < 256) { sF[(cur ^ 1) * 256 + tid] = sF[cur * 256 + tid] + (tid >= off ? sF[cur * 256 + tid - off] : 0.f);
                             sB[(cur ^ 1) * 256 + tid] = sB[cur * 256 + tid] + (tid >= off ? sB[cur * 256 + tid - off] : 0.f); }
            __syncthreads(); cur ^= 1;
        }
        float bF = 0.f, bB = 0.f, uF = 0.f, uB = 0.f;
        if (tid < 256) { bF = sF[cur * 256 + tid]; bB = sB[cur * 256 + 255 - tid]; uF = giF - bF; uB = giB - bB; mxs[tid] = uF; mxs[256 + tid] = uB; }
        __syncthreads();
        for (int off = 128; off >= 1; off >>= 1) { if (tid < off) { mxs[tid] = fmaxf(mxs[tid], mxs[tid + off]); mxs[256 + tid] = fmaxf(mxs[256 + tid], mxs[256 + tid + off]); } __syncthreads(); }
        const float cF = mxs[0], cB = mxs[256];
        if (tid < 256) { esF[tid] = __expf(uF - cF); esB[tid] = __expf(uB - cB); gb[tid] = bF; gb[256 + tid] = uF; gb[512 + tid] = bB; gb[768 + tid] = uB; }
        if (tid == 0) { gb[1024] = cF; gb[1025] = cB; gb[1026] = sF[cur * 256 + 255]; gb[1027] = sB[cur * 256 + 255]; }
        __syncthreads();
        const size_t seq0 = (size_t)bh * 2;
#pragma unroll 1
        for (int dir = 0; dir < 2; ++dir) {
            const LAS float* esd = dir ? esB : esF;
#pragma unroll
            for (int i = 0; i < 4; ++i) { const int piece = tid + NTHR * i, sr = piece >> 3, seg = piece & 7; const float ef = esd[sr];
                const unsigned wv[4] = {kreg[i].x, kreg[i].y, kreg[i].z, kreg[i].w}; u32x4 o; unsigned ov[4];
#pragma unroll
                for (int q = 0; q < 4; ++q) ov[q] = pk2(__builtin_bit_cast(float, wv[q] << 16) * ef, __builtin_bit_cast(float, wv[q] & 0xffff0000u) * ef);
                o.x = ov[0]; o.y = ov[1]; o.z = ov[2]; o.w = ov[3];
                *(LAS u32x4*)(Ks + sr * KP + seg * 8) = o; }
            __syncthreads();
            { const int d = tid & 63, part = tid >> 6; float sacc = 0.f;
#pragma unroll 8
                for (int ss = 0; ss < 32; ++ss) sacc += bf2f(Ks[(part * 32 + ss) * KP + d]);
                red[part * 64 + d] = sacc; }
            f32x4 acc[4];
#pragma unroll
            for (int dt = 0; dt < 4; ++dt) acc[dt] = (f32x4){0.f, 0.f, 0.f, 0.f};
#pragma unroll
            for (int ks = 0; ks < 8; ++ks) {
                const LAS bf16_t* vb = Vs + (32 * ks + 4 * fq + trq) * VP + 16 * wave + 4 * trp;
                const s16x4 x0 = __builtin_amdgcn_ds_read_tr16_b64_v4i16((LAS s16x4*)vb), x1 = __builtin_amdgcn_ds_read_tr16_b64_v4i16((LAS s16x4*)(vb + 16 * VP));
                const bf16x8 X = __builtin_shufflevector(x0, x1, 0, 1, 2, 3, 4, 5, 6, 7);
                const LAS bf16_t* kb_ = Ks + (32 * ks + 4 * fq + trq) * KP + 4 * trp;
#pragma unroll
                for (int dt = 0; dt < 4; ++dt) {
                    const s16x4 y0 = __builtin_amdgcn_ds_read_tr16_b64_v4i16((LAS s16x4*)(kb_ + 16 * dt)), y1 = __builtin_amdgcn_ds_read_tr16_b64_v4i16((LAS s16x4*)(kb_ + 16 * KP + 16 * dt));
                    const bf16x8 Y = __builtin_shufflevector(y0, y1, 0, 1, 2, 3, 4, 5, 6, 7);
                    acc[dt] = __builtin_amdgcn_mfma_f32_16x16x32_bf16(X, Y, acc[dt], 0, 0, 0); }
            }
            float* kl = (float*)(ws + WS_KLOC) + ((seq0 + dir) * 9 + ch) * 8192;
#pragma unroll
            for (int dt = 0; dt < 4; ++dt)
#pragma unroll
                for (int r = 0; r < 4; ++r) kl[(16 * wave + 4 * fq + r) * 64 + 16 * dt + fr] = acc[dt][r];
            __syncthreads();
            if (tid < 64) { float sacc = 0.f;
#pragma unroll
                for (int q = 0; q < 8; ++q) sacc += red[q * 64 + tid];
                ((float*)(ws + WS_NLOC))[((seq0 + dir) * 9 + ch) * 64 + tid] = sacc; }
            __syncthreads();
        }
    }
}
__device__ __forceinline__ void mlstm_m2(const Params& P) {
    const int tid = otid(), G = gridDim.x;
    unsigned char* ws = P.ws;
    for (int it = blockIdx.x; it < 256; it += G) {
        const int seq = it >> 1, half = it & 1, dir = seq & 1, bh = seq >> 1;
        const int e0 = half * 4096 + tid * 8;
        const float* kl = (const float*)(ws + WS_KLOC) + (size_t)seq * 9 * 8192 + e0;
        const float* nl = (const float*)(ws + WS_NLOC) + (size_t)seq * 9 * 64;
        const float* gbs = (const float*)(ws + WS_GBUF) + (size_t)bh * 9 * GB_STRIDE + 1024;
        bf16_t* cs = (bf16_t*)(ws + WS_CSTAR) + (size_t)seq * 8 * 8192 + e0;
        float* ns = (float*)(ws + WS_NSTAR) + (size_t)seq * 8 * 64; float* rb = (float*)(ws + WS_RBUF) + (size_t)seq * 8;
        const bool nthr = (half == 0 && tid < 64);
        float C[8], n = 0.f, m = 0.f;
#pragma unroll
        for (int i = 0; i < 8; ++i) C[i] = 0.f;
        f32x4 k0a[9], k1a[9]; float cca[9], bla[9], nla[9];
#pragma unroll
        for (int st = 0; st < 9; ++st) { const int ch = dir == 0 ? st : (st == 0 ? 0 : 9 - st);
            k0a[st] = *(const f32x4*)(kl + (size_t)ch * 8192); k1a[st] = *(const f32x4*)(kl + (size_t)ch * 8192 + 4);
            cca[st] = gbs[(size_t)ch * GB_STRIDE + dir]; bla[st] = gbs[(size_t)ch * GB_STRIDE + 2 + dir];
            nla[st] = nthr ? nl[ch * 64 + tid] : 0.f; }
#pragma unroll
        for (int st = 0; st < 9; ++st) {
            const int ch = dir == 0 ? st : (st == 0 ? 0 : 9 - st);
            const float cc = cca[st], bl = bla[st];
            if (ch >= 1) {
                const int tc = ch - 1; const float R = fmaxf(cc, m), sc = __expf(m - R);
                u32x4 w; w.x = pk2(C[0] * sc, C[1] * sc); w.y = pk2(C[2] * sc, C[3] * sc); w.z = pk2(C[4] * sc, C[5] * sc); w.w = pk2(C[6] * sc, C[7] * sc);
                *(u32x4*)(cs + (size_t)tc * 8192) = w;
                if (nthr) ns[tc * 64 + tid] = n * sc;
                if (half == 0 && tid == 0) rb[tc] = R;
            }
            if (st < 8) {
                const float mloc = bl + cc, mnew = fmaxf(bl + m, mloc), a = __expf(bl + m - mnew), bb = __expf(mloc - mnew);
                const f32x4 k0 = k0a[st], k1 = k1a[st];
                C[0] = a * C[0] + bb * k0.x; C[1] = a * C[1] + bb * k0.y; C[2] = a * C[2] + bb * k0.z; C[3] = a * C[3] + bb * k0.w;
                C[4] = a * C[4] + bb * k1.x; C[5] = a * C[5] + bb * k1.y; C[6] = a * C[6] + bb * k1.z; C[7] = a * C[7] + bb * k1.w;
                if (nthr) n = a * n + bb * nla[st];
                m = mnew;
            }
        }
    }
}
__device__ __forceinline__ void mlstm_m3(const Params& P, LAS unsigned char* lds) {
    const int tid = otid(), lane = tid & 63, wave = __builtin_amdgcn_readfirstlane(tid >> 6), G = gridDim.x, fr = lane & 15, fq = lane >> 4;
    unsigned char* ws = P.ws;
    const bf16_t* pb = (const bf16_t*)(ws + WS_BIG);
    constexpr int VP = 144;
    LAS bf16_t* Vs = (LAS bf16_t*)lds;
    LAS bf16_t* Ks = Vs + 256 * VP;
    LAS bf16_t* Cs = Ks + 256 * 64;
    LAS float* fa = (LAS float*)(Cs + 2 * 128 * 64);
    LAS float* es = fa;
    LAS float* low = fa + 512;
    LAS float* n0 = fa + 1024;
    bf16_t* A = (bf16_t*)(ws + WS_ABF);
    const int trq = (lane & 15) >> 2, trp = lane & 3;
    for (int it = blockIdx.x; it < NB * NH * 8; it += G) {
        const int tc = it & 7, bh = it >> 3, h = bh & 7, b = bh >> 3;
        const int row0 = b * T + tc * 256;
        const float* gb = (const float*)(ws + WS_GBUF) + (size_t)(bh * 9 + tc + 1) * GB_STRIDE;
        const size_t seq0 = (size_t)bh * 2;
        const float* rbuf = (const float*)(ws + WS_RBUF);
        {
            const int dir = tid >> 8, sidx = tid & 255;
            const float R = rbuf[(seq0 + dir) * 8 + tc];
            const float bb = gb[dir * 512 + sidx], uu = gb[dir * 512 + 256 + sidx];
            es[dir * 256 + sidx] = __expf(uu - R); low[dir * 256 + sidx] = __expf(fminf(-bb - R, 80.f));
            if (tid < 128) n0[tid] = ((const float*)(ws + WS_NSTAR))[((seq0 + (tid >> 6)) * 8 + tc) * 64 + (tid & 63)];
        }
#pragma unroll
        for (int i = 0; i < 4; ++i) { const int piece = tid + NTHR * i, sr = piece >> 3, seg = piece & 7;
            *(LAS u32x4*)(Ks + sr * 64 + ((seg ^ (sr & 7)) << 3)) = *(const u32x4*)(pb + (size_t)(row0 + sr) * NQKVO + 512 + h * 64 + seg * 8); }
#pragma unroll
        for (int i = 0; i < 4; ++i) { const int piece = tid + NTHR * i, cr = piece >> 3, seg = piece & 7;
            *(LAS u32x4*)(Cs + cr * 64 + ((seg ^ (cr & 7)) << 3)) = *(const u32x4*)((const bf16_t*)(ws + WS_CSTAR) + ((seq0 + (cr >> 7)) * 8 + tc) * 8192 + (cr & 127) * 64 + seg * 8); }
#pragma unroll
        for (int i = 0; i < 8; ++i) { const int piece = tid + NTHR * i, sr = piece >> 4, seg = piece & 15;
            *(LAS u32x4*)(Vs + sr * VP + seg * 8) = *(const u32x4*)(pb + (size_t)(row0 + sr) * NQKVO + 1024 + h * 128 + seg * 8); }
        bf16x8 Qa[2][2];
#pragma unroll
        for (int rti = 0; rti < 2; ++rti)
#pragma unroll
            for (int kk = 0; kk < 2; ++kk) Qa[rti][kk] = *(const bf16x8*)(pb + (size_t)(row0 + 16 * (wave + 8 * rti) + fr) * NQKVO + h * 64 + 32 * kk + 8 * fq);
        __syncthreads();
#pragma unroll
        for (int rti = 0; rti < 2; ++rti) {
            const int rt = wave + 8 * rti, rw = rt >> 1, jl0 = 16 * (rt & 1);
            const bf16x8 Qf[2] = {Qa[rti][0], Qa[rti][1]};
            const size_t row = (size_t)(row0 + 16 * rt + fr);
            u32x2 ow[8];
#pragma unroll
            for (int dvt = 0; dvt < 8; ++dvt) ow[dvt] = *(const u32x2*)(pb + row * NQKVO + 2048 + h * 128 + 16 * dvt + 4 * fq);
            f32x4 hs[8];
#pragma unroll
            for (int dvt = 0; dvt < 8; ++dvt) hs[dvt] = (f32x4){0.f, 0.f, 0.f, 0.f};
#pragma unroll 1
            for (int dir = 0; dir < 2; ++dir) {
                f32x4 acc[8]; float den = 0.f;
#pragma unroll
                for (int dvt = 0; dvt < 8; ++dvt) acc[dvt] = (f32x4){0.f, 0.f, 0.f, 0.f};
#pragma unroll
                for (int dvt = 0; dvt < 8; ++dvt)
#pragma unroll
                    for (int kk = 0; kk < 2; ++kk) { const int cr = dir * 128 + 16 * dvt + fr;
                        const bf16x8 Cf = *(const LAS bf16x8*)(Cs + cr * 64 + (((4 * kk + fq) ^ (cr & 7)) << 3));
                        acc[dvt] = __builtin_amdgcn_mfma_f32_16x16x32_bf16(Cf, Qf[kk], acc[dvt], 0, 0, 0); }
#pragma unroll
                for (int kk = 0; kk < 2; ++kk)
#pragma unroll
                    for (int e = 0; e < 8; ++e) den += n0[dir * 64 + 32 * kk + 8 * fq + e] * bf2f((unsigned short)Qf[kk][e]);
                const int sb_lo = dir == 0 ? 0 : rw, sb_hi = dir == 0 ? rw : 7;
#pragma unroll 2
                for (int sb = sb_lo; sb <= sb_hi; ++sb) {
                    const int s0 = 32 * sb; const bool diag = (sb == rw);
                    f32x4 ST[2];
#pragma unroll
                    for (int st = 0; st < 2; ++st) { ST[st] = (f32x4){0.f, 0.f, 0.f, 0.f};
#pragma unroll
                        for (int kk = 0; kk < 2; ++kk) { const int sr = s0 + 16 * st + fr;
                            const bf16x8 Kf = *(const LAS bf16x8*)(Ks + sr * 64 + (((4 * kk + fq) ^ (sr & 7)) << 3));
                            ST[st] = __builtin_amdgcn_mfma_f32_16x16x32_bf16(Kf, Qf[kk], ST[st], 0, 0, 0); } }
                    float pv[8];
#pragma unroll
                    for (int st = 0; st < 2; ++st) { const f32x4 ev = *(const LAS f32x4*)(es + dir * 256 + s0 + 16 * st + 4 * fq);
#pragma unroll
                        for (int r = 0; r < 4; ++r) { const int sl = 16 * st + 4 * fq + r, jl = jl0 + fr;
                            float v = ST[st][r] * ev[r];
                            if (diag) { const bool keep = dir == 0 ? (sl <= jl) : (sl >= jl); v = keep ? v : 0.f; }
                            pv[4 * st + r] = v; den += v; } }
                    u32x4 pw; pw.x = pk2(pv[0], pv[1]); pw.y = pk2(pv[2], pv[3]); pw.z = pk2(pv[4], pv[5]); pw.w = pk2(pv[6], pv[7]);
                    const bf16x8 Pb = __builtin_bit_cast(bf16x8, pw);
                    const LAS bf16_t* vb = Vs + (s0 + 4 * fq + trq) * VP + 4 * trp;
#pragma unroll
                    for (int dvt = 0; dvt < 8; ++dvt) {
                        const s16x4 v0 = __builtin_amdgcn_ds_read_tr16_b64_v4i16((LAS s16x4*)(vb + 16 * dvt));
                        const s16x4 v1 = __builtin_amdgcn_ds_read_tr16_b64_v4i16((LAS s16x4*)(vb + 16 * VP + 16 * dvt));
                        const bf16x8 Vf = __builtin_shufflevector(v0, v1, 0, 1, 2, 3, 4, 5, 6, 7);
                        acc[dvt] = __builtin_amdgcn_mfma_f32_16x16x32_bf16(Vf, Pb, acc[dvt], 0, 0, 0);
                    }
                }
                float dn = den; dn += __shfl_xor(dn, 16); dn += __shfl_xor(dn, 32);
                const float inv = __builtin_amdgcn_rcpf(fmaxf(fabsf(dn), low[dir * 256 + 16 * rt + fr]));
#pragma unroll
                for (int dvt = 0; dvt < 8; ++dvt) hs[dvt] = hs[dvt] + acc[dvt] * inv;
            }
            float ss = 0.f;
#pragma unroll
            for (int dvt = 0; dvt < 8; ++dvt) { const f32x4 v = hs[dvt]; ss += (v.x * v.x + v.y * v.y) + (v.z * v.z + v.w * v.w); }
            ss += __shfl_xor(ss, 16); ss += __shfl_xor(ss, 32);
            const float rn = rsqrtf(ss * (1.f / DV) + EPS);
            f32x4 ngv[8];
#pragma unroll
            for (int dvt = 0; dvt < 8; ++dvt) ngv[dvt] = *(const f32x4*)(P.mlstm_norm + h * 128 + 16 * dvt + 4 * fq);
#pragma unroll
            for (int dvt = 0; dvt < 8; ++dvt) { const int col = h * 128 + 16 * dvt + 4 * fq;
                const f32x4 ng = ngv[dvt];
                const float o0 = sigmoidf(__builtin_bit_cast(float, ow[dvt].x << 16)), o1 = sigmoidf(__builtin_bit_cast(float, ow[dvt].x & 0xffff0000u)),
                            o2 = sigmoidf(__builtin_bit_cast(float, ow[dvt].y << 16)), o3 = sigmoidf(__builtin_bit_cast(float, ow[dvt].y & 0xffff0000u));
                const f32x4 v = hs[dvt] * rn * ng;
                *(unsigned*)((unsigned char*)A + row * D + col) = pk4_fp8(v.x * o0 * ACT_SCALE, v.y * o1 * ACT_SCALE, v.z * o2 * ACT_SCALE, v.w * o3 * ACT_SCALE); }
        }
        __syncthreads();
    }
}

#ifndef GEMM_BODY
#define GEMM_BODY gemm_pipe<false>
#endif
enum { PH_P0 = 0, PH_VP, PH_POOLG, PH_NORM0, PH_TOPK0, PH_G1_0, PH_G2_0, PH_COMB0, PH_INPROJ, PH_M1, PH_M2, PH_M3, PH_OUTG, PH_NORM1, PH_TOPK1, PH_G1_1, PH_G2_1, PH_COMB1, PH_COUNT };

template <int PH>
__device__ __forceinline__ void run_phase(const Params& P, LAS unsigned char* lds) {
    unsigned char* ws = P.ws;
    const float* mod0 = (const float*)(ws + WS_MOD); const float* mod1 = mod0 + 9 * NADA;
    float* XA = (float*)(ws + WS_XA); float* XB = (float*)(ws + WS_XB); bf16_t* ABF = (bf16_t*)(ws + WS_ABF);
    const int G = gridDim.x, vc = vcu_of_block();
    if constexpr (PH == PH_P0) { phase1(P, lds); phase0(P, lds); }
    else if constexpr (PH == PH_VP) { ctx_pool(P); phase2(P, lds); }
    else if constexpr (PH == PH_POOLG) {
        GemmDesc g{ABF, D, nullptr, (const bf16_t*)(ws + WS_POOLWT), 256, 256};
        SchedGrid S{NX / 256, 4, G, vc, 256, 1};
        EpiResid<true> E{(const bf16_t*)XB, (const bf16_t*)XB, (bf16_t*)XA, mod0 + 2 * D, P.pool_scale};
        GEMM_BODY(lds, g, S, E);
        pool_ctx_subtiles(P, (bf16_t*)XA);
    } else if constexpr (PH == PH_NORM0) norm_router_mfma(lds, (const bf16_t*)XA, NR, P.norm_ffn, mod0, 3, (unsigned char*)ABF, P.router, (float*)(ws + WS_AFF));
    else if constexpr (PH == PH_TOPK0) phase_topk(P, lds, true);
    else if constexpr (PH == PH_G1_0 || PH == PH_G1_1) {
        constexpr int L = PH == PH_G1_1;
        GemmDesc g{ABF, D, (const int*)(ws + WS_ROWTAB), (const bf16_t*)(ws + WS_WGUT), D, D};
        SchedMoe S{L ? 128 : 144, 16, G, vc, L * NE * 16};
        EpiSwigluF8 E{(unsigned char*)(ws + WS_BIG)};
        gemm_pipe<true>(lds, g, S, E);
    } else if constexpr (PH == PH_G2_0 || PH == PH_G2_1) {
        constexpr int L = PH == PH_G2_1;
        GemmDesc g{(const bf16_t*)(ws + WS_BIG), FH, nullptr, (const bf16_t*)(ws + WS_WDT), FH, FH};
        SchedMoe S{L ? 128 : 144, 4, G, vc, L * NE * 4};
        EpiYsF8 E{(unsigned char*)(ws + WS_YS)};
        gemm_pipe<true>(lds, g, S, E);
        if constexpr (!L) { if (G == 256 && vc >= 64) f8_convert_range(P, lds, F8_S2, F8_N2, (vc - 64) * 8 + __builtin_amdgcn_readfirstlane(otid() >> 6), 192 * 8, 1 << 30, 0); }
    } else if constexpr (PH == PH_COMB0) combine_rows(P, (const bf16_t*)XA, (bf16_t*)XB, NR, mod0, P.norm_mix + D, mod1, ABF, nullptr, nullptr);
    else if constexpr (PH == PH_INPROJ) {
        GemmDesc g{ABF, D, nullptr, (const bf16_t*)(ws + WS_WINT), D, D};
        SchedInproj S{G, vc};
        EpiInproj E{(bf16_t*)(ws + WS_BIG), (float*)(ws + WS_GATES), P.b_gates};
        GEMM_BODY(lds, g, S, E);
        if (G == 256 && vc >= 120) f8_convert_range(P, lds, F8_S3, F8_N3, (vc - 120) * 8 + __builtin_amdgcn_readfirstlane(otid() >> 6), 136 * 8, 1 << 30, 0);
    } else if constexpr (PH == PH_M1) { mlstm_m1(P, lds);
        if (G == 256 && blockIdx.x >= 64) f8_convert_range(P, lds, F8_S5, F8_N5, (blockIdx.x - 64) * 8 + __builtin_amdgcn_readfirstlane(otid() >> 6), 192 * 8, 1 << 30, 0); }
    else if constexpr (PH == PH_M2) mlstm_m2(P);
    else if constexpr (PH == PH_M3) mlstm_m3(P, lds);
    else if constexpr (PH == PH_OUTG) {
        GemmDesc g{ABF, D, nullptr, (const bf16_t*)(ws + WS_WOUTT), D, D};
        SchedGrid S{NX / 256, 4, G, vc, 0, 1};
        EpiResid<true> E{(const bf16_t*)XB, (const bf16_t*)XB + (size_t)NX * D, (bf16_t*)XA, mod1 + 2 * D, nullptr};
        gemm_pipe<true>(lds, g, S, E);
    } else if constexpr (PH == PH_NORM1) norm_router_mfma(lds, (const bf16_t*)XA, NX, P.norm_ffn + D, mod1, 3, (unsigned char*)ABF, P.router + D * NE, (float*)(ws + WS_AFF));
    else if constexpr (PH == PH_TOPK1) phase_topk(P, lds, false);
    else if constexpr (PH == PH_COMB1) combine_rows(P, (const bf16_t*)XA, nullptr, NX, mod1, nullptr, nullptr, nullptr, P.out, P.final_norm);
}


#define GAS __attribute__((address_space(1)))
#define XB_TMO      128
#define XB_XCNT(j)  (256  + 64 * (j))
#define XB_XSUB(j)  (1280 + 64 * (j))
#define XB_XGEN(j)  (2304 + 64 * (j))
#define XB_TOP      3328
#define XB_TOPGEN   3392
#define XCD_BAR_WORDS 3456
#define XB_SPIN_CAP (1u << 18)
__device__ __forceinline__ unsigned xb_ld(unsigned* p)              { return __hip_atomic_load(p, __ATOMIC_RELAXED, __HIP_MEMORY_SCOPE_AGENT); }
__device__ __forceinline__ unsigned xb_add(unsigned* p, unsigned v) { return __hip_atomic_fetch_add(p, v, __ATOMIC_RELAXED, __HIP_MEMORY_SCOPE_AGENT); }
__device__ __forceinline__ unsigned xb_xcc_id() { return (unsigned)__builtin_amdgcn_s_getreg((3 << 11) | 20) & 0xFu; }
#define XB_SPIN(cond, bar) do { unsigned _sp = 0; while (cond) { __builtin_amdgcn_s_sleep(1); \
    if ((++_sp & 255u) == 0u) { if (xb_ld(&(bar)[XB_TMO])) break; if (_sp > XB_SPIN_CAP) { atomicAdd(&(bar)[XB_TMO], 1u); break; } } } } while (0)
struct XcdBarrier { unsigned* bar; unsigned x; volatile LAS unsigned* st; };
__device__ __forceinline__ XcdBarrier xcd_barrier_post(unsigned* bar, volatile LAS unsigned* st) {
    XcdBarrier b; b.bar = bar; b.x = xb_xcc_id(); b.st = st;
    if (threadIdx.x == 0) (void)xb_add(&bar[XB_XCNT(b.x)], 1u);
    return b;
}
__device__ __forceinline__ void xcd_barrier_complete(unsigned* bar, unsigned x, unsigned& nloc, unsigned& nx) {
    const unsigned G = gridDim.x * gridDim.y * gridDim.z;
    unsigned sum, cnt, mine, sp = 0u;
    for (;;) {
        sum = 0u; cnt = 0u; mine = 0u;
#pragma unroll
        for (unsigned j = 0; j < 16; ++j) { const unsigned c = xb_ld(&bar[XB_XCNT(j)]); sum += c; cnt += (c > 0u) ? 1u : 0u; mine = (j == x) ? c : mine; }
        if (sum == G) break;
        __builtin_amdgcn_s_sleep(1);
        if ((++sp & 255u) == 0u) { if (xb_ld(&bar[XB_TMO])) break; if (sp > XB_SPIN_CAP) { atomicAdd(&bar[XB_TMO], 1u); break; } }
    }
    nloc = mine > 0u ? mine : 1u; nx = cnt > 0u ? cnt : 1u;
}
__device__ __forceinline__ void xcd_barrier(const XcdBarrier& b) {
    asm volatile("s_waitcnt vmcnt(0)" ::: "memory");
    __syncthreads();
    if (threadIdx.x == 0) {
        unsigned* bar = b.bar;
        __builtin_amdgcn_s_waitcnt(0);
        unsigned nloc = b.st[0], nx = b.st[1];
        if (nloc == 0u) { xcd_barrier_complete(bar, b.x, nloc, nx); b.st[0] = nloc; b.st[1] = nx; }
        const unsigned old = xb_add(&bar[XB_XSUB(b.x)], 1u);
        const unsigned gen = old / nloc;
        if (old + 1u == (gen + 1u) * nloc) {
            __builtin_amdgcn_fence(__ATOMIC_RELEASE, "agent");
            asm volatile("s_waitcnt vmcnt(0)" ::: "memory");
            const unsigned og = xb_add(&bar[XB_TOP], 1u);
            const unsigned tg = og / nx;
            if (og + 1u == (tg + 1u) * nx) xb_add(&bar[XB_TOPGEN], 1u);
            else XB_SPIN(xb_ld(&bar[XB_TOPGEN]) == tg, bar);
            __builtin_amdgcn_fence(__ATOMIC_ACQUIRE, "agent");
            xb_add(&bar[XB_XGEN(b.x)], 1u);
            asm volatile("s_waitcnt vmcnt(0)" ::: "memory");
        } else {
            XB_SPIN(xb_ld(&bar[XB_XGEN(b.x)]) == gen, bar);
            __builtin_amdgcn_fence(__ATOMIC_ACQUIRE, "agent");
            asm volatile("s_waitcnt vmcnt(0)" ::: "memory");
        }
    }
    __syncthreads();
}
constexpr int CW_BAR = 4096;
constexpr size_t CTL_ZERO_BYTES = 65536;

#ifndef PROBE_NORM
#define PROBE_NORM 0
#endif
#ifndef EXTRA_BARRIERS
#define EXTRA_BARRIERS 0
#endif
#ifndef DUP_MASK_V
#define DUP_MASK_V 0ull
#endif
constexpr unsigned long long DUP_MASK = DUP_MASK_V;
template <int PH>
__device__ __forceinline__ void run_from(const Params& P, LAS unsigned char* lds, const XcdBarrier& bar) {
    if constexpr (PH == 0 && PROBE_P0R == 1) { probe_p0_readonly(P, lds); xcd_barrier(bar); }
    if constexpr (PH == PH_NORM0 && PROBE_NORM == 1) { norm_rows<false, true>(lds, (const float*)(P.ws + WS_XA), NR, P.norm_ffn, (const float*)(P.ws + WS_MOD), 3, (bf16_t*)(P.ws + WS_ABF), P.router, (float*)(P.ws + WS_AFF)); xcd_barrier(bar); }
    if constexpr (PH == PH_INPROJ && EXTRA_BARRIERS > 0) { for (int i = 0; i < EXTRA_BARRIERS; ++i) xcd_barrier(bar); }
    if constexpr ((DUP_MASK >> PH) & 1ull) { run_phase<PH>(P, lds); xcd_barrier(bar); }
    run_phase<PH>(P, lds);
    if constexpr (PH + 1 < PH_COUNT) { xcd_barrier(bar); run_from<PH + 1>(P, lds, bar); }
}
__global__ void __launch_bounds__(NTHR, 2) mega_kernel(Params P) {
    extern __shared__ __attribute__((aligned(16))) unsigned char lds_raw[];
    LAS unsigned char* lds = (LAS unsigned char*)lds_raw;
    volatile LAS unsigned* st = (volatile LAS unsigned*)(lds + LDS_BYTES - 64);
    if (threadIdx.x < 16) st[threadIdx.x] = 0u;
    __syncthreads();
    const XcdBarrier bar = xcd_barrier_post((unsigned*)(P.ws + WS_CTL) + CW_BAR, st);
    run_from<0>(P, lds, bar);
}

extern "C" void kernel_launch(void* const* d_in, const int* in_sizes, int n_in, void* d_out, int out_size, void* d_ws, size_t ws_size, hipStream_t stream) {
    static int grid = 0;
    if (grid == 0) {
        if (n_in != 19 || ws_size < WS_END) { fprintf(stderr, "kernel_launch: unexpected n_in %d / ws_size %zu (need %zu)\n", n_in, ws_size, (size_t)WS_END); grid = -1; return; }
        int dev = 0, cus = 0, per_cu = 0;
        if (hipGetDevice(&dev) != hipSuccess || hipDeviceGetAttribute(&cus, hipDeviceAttributeMultiprocessorCount, dev) != hipSuccess) { grid = -1; return; }
        if (hipFuncSetAttribute((const void*)mega_kernel, hipFuncAttributeMaxDynamicSharedMemorySize, LDS_BYTES) != hipSuccess) { fprintf(stderr, "kernel_launch: hipFuncSetAttribute failed\n"); grid = -1; return; }
        if (hipOccupancyMaxActiveBlocksPerMultiprocessor(&per_cu, (const void*)mega_kernel, NTHR, LDS_BYTES) != hipSuccess || per_cu < 1) { fprintf(stderr, "kernel_launch: occupancy query says %d blocks/CU\n", per_cu); (void)hipGetLastError(); grid = -1; return; }
        grid = cus;
    }
    if (grid < 0) return;
    (void)hipMemsetAsync(d_ws, 0, CTL_ZERO_BYTES, stream);
    Params P{};
    const float** pp = (const float**)&P;
    for (int i = 0; i < 19; ++i) pp[i] = (const float*)d_in[i];
    P.out = (float*)d_out; P.ws = (unsigned char*)d_ws;
    hipLaunchKernelGGL(mega_kernel, dim3(grid), dim3(NTHR), LDS_BYTES, stream, P);
}

#ifdef PHASE_KERNELS
template <int PH>
__global__ void __launch_bounds__(NTHR, 2) phase_kernel(Params P) {
    extern __shared__ __attribute__((aligned(16))) unsigned char lds_raw2[];
    run_phase<PH>(P, (LAS unsigned char*)lds_raw2);
}
#define INST(n) template __global__ void phase_kernel<n>(Params);
INST(0) INST(1) INST(2) INST(3) INST(4) INST(5) INST(6) INST(7) INST(8) INST(9) INST(10) INST(11) INST(12) INST(13) INST(14) INST(15) INST(16) INST(17)
#endif
```

```cpp
#include <hip/hip_runtime.h>
#include <cstdint>
#include <cstdio>

#define LAS __attribute__((address_space(3)))
typedef unsigned short bf16_t;
typedef short bf16x8 __attribute__((ext_vector_type(8)));
typedef short bf16x4 __attribute__((ext_vector_type(4)));
typedef float f32x4 __attribute__((ext_vector_type(4)));
typedef float f32x2 __attribute__((ext_vector_type(2)));
typedef unsigned u32x4 __attribute__((ext_vector_type(4)));
typedef unsigned u32x2 __attribute__((ext_vector_type(2)));

constexpr int D = 1024, NB = 8, T = 2048, TC = 256, NX = NB * T, NCX = NB * TC, NR = NX + NCX;
constexpr int NE = 16, FH = 2048, CAPX = 256, CAPC = 32;
constexpr int NH = 8, DK = 64, DV = 128, NIN = 3104, NINP = 3328, NQKVO = 3072;
constexpr int NADA = 6 * D;
constexpr float EPS = 1e-6f;
constexpr int NTHR = 512;
constexpr int NUNITM = 144;
constexpr int LDS_BYTES = 147456;

constexpr size_t al256(size_t x) { return (x + 255) & ~(size_t)255; }
constexpr size_t WS_CTL = 0;
constexpr size_t WS_MOD = 1u << 20;
constexpr size_t WS_RSX = WS_MOD + al256((size_t)2 * 9 * NADA * 4);
constexpr size_t WS_AFF = WS_RSX + al256((size_t)NR * 4);
constexpr size_t WS_AFFC = WS_AFF + (size_t)NB * NE * T * 4;
constexpr size_t WS_POS = WS_AFFC + (size_t)NB * NE * TC * 4;
constexpr size_t WS_POSC = WS_POS + (size_t)NB * NE * T * 4;
constexpr size_t WS_ROWTAB = WS_POSC + (size_t)NB * NE * TC * 4;
constexpr size_t WS_GATES = WS_ROWTAB + (size_t)NUNITM * 256 * 4;
constexpr size_t WS_GBUF = WS_GATES + (size_t)NR * 32 * 4;
constexpr int GB_STRIDE = 1040;
constexpr size_t WS_NLOC = WS_GBUF + (size_t)NB * NH * 9 * GB_STRIDE * 4;
constexpr size_t WS_NSTAR = WS_NLOC + (size_t)128 * 9 * 64 * 4;
constexpr size_t WS_RBUF = WS_NSTAR + (size_t)128 * 8 * 64 * 4;
constexpr size_t WS_POOLWT = al256(WS_RBUF + 128 * 8 * 4);
constexpr size_t WS_WINT = WS_POOLWT + (size_t)4 * 256 * 256 * 2;
constexpr size_t WS_WOUTT = WS_WINT + (size_t)NINP * D * 2;
constexpr size_t WS_WGUT = WS_WOUTT + (size_t)D * D * 2;
constexpr size_t WS_WDT = WS_WGUT + (size_t)2 * NE * 4096 * D * 2;
constexpr size_t WS_XA = WS_WDT + (size_t)2 * NE * D * FH * 2;
constexpr size_t WS_XB = WS_XA + (size_t)NR * D * 4;
constexpr size_t WS_ABF = WS_XB + (size_t)NR * D * 4;
constexpr size_t WS_BIG = WS_ABF + (size_t)NR * D * 2;
constexpr size_t WS_YS = WS_BIG + (size_t)NUNITM * 256 * FH * 2;
constexpr size_t WS_KLOC = WS_YS;
constexpr size_t WS_CSTAR = WS_KLOC + (size_t)128 * 9 * 8192 * 4;
constexpr size_t WS_END = WS_YS + (size_t)NUNITM * 256 * D * 2;
static_assert(WS_CSTAR + (size_t)128 * 8 * 8192 * 2 <= WS_END, "ws map");
static_assert(WS_END <= ((size_t)1 << 30), "ws fits 1 GiB");

struct Params {
    const float *x, *c, *ctx, *c_ctx, *ada_w, *ada_b, *norm_mix, *norm_ffn, *pool_w, *pool_scale, *w_in, *b_gates, *mlstm_norm, *w_out,
                *router, *w_gate, *w_up, *w_down, *final_norm;
    float* out;
    unsigned char* ws;
};

__device__ __forceinline__ unsigned f2bf(float f) { unsigned u = __builtin_bit_cast(unsigned, f); return (u + 0x7fffu + ((u >> 16) & 1u)) >> 16; }
typedef __bf16 bf16n2 __attribute__((ext_vector_type(2)));
__device__ __forceinline__ unsigned pk2(float lo, float hi) { return __builtin_bit_cast(unsigned, __builtin_convertvector((f32x2){lo, hi}, bf16n2)); }
typedef _Float16 f16n2 __attribute__((ext_vector_type(2)));
__device__ __forceinline__ unsigned pkr(float lo, float hi) { return __builtin_bit_cast(unsigned, __builtin_convertvector((f32x2){lo, hi}, f16n2)); }
__device__ __forceinline__ f32x2 unr(unsigned w) { return __builtin_convertvector(__builtin_bit_cast(f16n2, w), f32x2); }
__device__ __forceinline__ float bf2f(unsigned short h) { return __builtin_bit_cast(float, (unsigned)h << 16); }
__device__ __forceinline__ float wave_sum(float v) {
#pragma unroll
    for (int o = 1; o < 64; o <<= 1) v += __shfl_xor(v, o);
    return v;
}
typedef int v8i32 __attribute__((ext_vector_type(8)));
constexpr float ACT_SCALE = 8.f, W_SCALE = 64.f, HID_SCALE = 8.f;
__device__ __forceinline__ float clamp448(float v) { return __builtin_amdgcn_fmed3f(v, -448.f, 448.f); }
__device__ __forceinline__ unsigned pk4_fp8(float a, float b, float c, float d) {
    int w = 0;
    w = __builtin_amdgcn_cvt_pk_fp8_f32(clamp448(a), clamp448(b), w, false);
    w = __builtin_amdgcn_cvt_pk_fp8_f32(clamp448(c), clamp448(d), w, true);
    return (unsigned)w;
}
__device__ __forceinline__ int otid() { int t = threadIdx.x; asm volatile("" : "+v"(t)); return t; }
__device__ __forceinline__ float siluf(float v) { return v * __builtin_amdgcn_rcpf(1.f + __expf(-v)); }
__device__ __forceinline__ float sigmoidf(float v) { return __builtin_amdgcn_rcpf(1.f + __expf(-v)); }
__device__ __forceinline__ float logsigmoidf(float v) { return fminf(v, 0.f) - log1pf(__expf(-fabsf(v))); }
__device__ __forceinline__ int pool_w_of_group(int j) { return 2 << j; }

struct Unit { int pm, pb, pn, koff; };
struct GemmDesc { const bf16_t* A; int lda; const int* rowtab; const bf16_t* Bt; int ldb; int K; };
__device__ __forceinline__ int perm32(int rho) { const int n = rho >> 4, i = rho & 15; return 8 * (i >> 2) + 4 * n + (i & 3); }

template <class Epi, class Sched>
__device__ __forceinline__ void gemm_simple(LAS unsigned char* lds, const GemmDesc g, const Sched& S, const Epi& E) {
    const int tid = otid(), wid = __builtin_amdgcn_readfirstlane(tid >> 6), lane = tid & 63, wr = wid >> 2, wc = wid & 3, fr = lane & 15, fq = lane >> 4;
    constexpr int PITCH = 72;
    LAS bf16_t* As = (LAS bf16_t*)lds;
    LAS bf16_t* Bs = As + 256 * PITCH;
    Unit u;
    for (int ui = 0; S.next(ui, u); ++ui) {
        f32x4 acc[2][2][4][2];
#pragma unroll
        for (int a = 0; a < 2; ++a)
#pragma unroll
            for (int b = 0; b < 2; ++b)
#pragma unroll
                for (int m = 0; m < 4; ++m)
#pragma unroll
                    for (int n = 0; n < 2; ++n) acc[a][b][m][n] = (f32x4){0.f, 0.f, 0.f, 0.f};
        size_t aoff[4], boff[4]; int lof[4];
#pragma unroll
        for (int i = 0; i < 4; ++i) {
            const int piece = tid + NTHR * i, row = piece >> 3, cs = piece & 7;
            const int arow = g.rowtab ? g.rowtab[u.pm * 256 + row] : u.pm * 256 + row;
            aoff[i] = (size_t)arow * g.lda + u.koff + cs * 8;
            const int brow = u.pb * 256 + (row & ~31) + perm32(row & 31);
            boff[i] = (size_t)brow * g.ldb + cs * 8;
            lof[i] = row * PITCH + cs * 8;
        }
        for (int kt = 0; kt < g.K; kt += 64) {
            u32x4 av[4], bv[4];
#pragma unroll
            for (int i = 0; i < 4; ++i) { av[i] = *(const u32x4*)(g.A + aoff[i] + kt); bv[i] = *(const u32x4*)(g.Bt + boff[i] + kt); }
            __syncthreads();
#pragma unroll
            for (int i = 0; i < 4; ++i) { *(LAS u32x4*)(As + lof[i]) = av[i]; *(LAS u32x4*)(Bs + lof[i]) = bv[i]; }
            __syncthreads();
#pragma unroll
            for (int k = 0; k < 2; ++k) {
                bf16x8 Af[2][4], Bf[2][2];
#pragma unroll
                for (int ai = 0; ai < 2; ++ai)
#pragma unroll
                    for (int m = 0; m < 4; ++m) Af[ai][m] = *(const LAS bf16x8*)(As + (128 * ai + 64 * wr + 16 * m + fr) * PITCH + 32 * k + 8 * fq);
#pragma unroll
                for (int bj = 0; bj < 2; ++bj)
#pragma unroll
                    for (int n = 0; n < 2; ++n) Bf[bj][n] = *(const LAS bf16x8*)(Bs + (128 * bj + 32 * wc + 16 * n + fr) * PITCH + 32 * k + 8 * fq);
#pragma unroll
                for (int ai = 0; ai < 2; ++ai)
#pragma unroll
                    for (int bj = 0; bj < 2; ++bj)
#pragma unroll
                        for (int m = 0; m < 4; ++m)
#pragma unroll
                            for (int n = 0; n < 2; ++n) acc[ai][bj][m][n] = __builtin_amdgcn_mfma_f32_16x16x32_bf16(Bf[bj][n], Af[ai][m], acc[ai][bj][m][n], 0, 0, 0);
            }
        }
        E(acc, u, wr, wc, fr, fq);
        __syncthreads();
    }
}


constexpr int HTB = 128 * 64 * 2, STAGE_BYTES = 8 * HTB, TAB_OFF = STAGE_BYTES;
__device__ __forceinline__ int lds_byte(int r, int c) { const int st = (r >> 4) * 2 + (c >> 5), rr = r & 15, cc = c & 31, ob = rr * 64 + cc * 2; return st * 1024 + (ob ^ (((ob >> 9) & 1) << 5)); }
__device__ __forceinline__ void stage_rc(int b, int& R, int& C) { const int st = b / 1024, sb = b % 1024, swz = sb ^ (((sb >> 9) & 1) << 5); R = (st >> 1) * 16 + swz / 64; C = (st & 1) * 32 + (swz % 64) / 2; }

struct GpLead { static constexpr bool value = true; }; struct GpTrail { static constexpr bool value = false; };
template <bool FP8, class Epi, class Sched>
__device__ __forceinline__ void gemm_pipe(LAS unsigned char* lds, const GemmDesc g, const Sched& S, const Epi& E) {
    constexpr int ESZ = FP8 ? 1 : 2;
    const int tid = otid(), wid = __builtin_amdgcn_readfirstlane(tid >> 6), lane = tid & 63, wr = wid >> 2, wc = wid & 3, fr = lane & 15, fq = lane >> 4;
    const int nt = g.K * ESZ / 128;
    int R0, C0; stage_rc(tid * 16, R0, C0);
    const int rc = R0 | (C0 << 8);
    unsigned voffB[2];
    { const int Rb = (R0 & ~31) + perm32(R0 & 31); voffB[0] = (unsigned)(Rb * g.ldb * ESZ + C0 * 2); voffB[1] = voffB[0] + (unsigned)(64 * g.ldb * ESZ); }
    Unit cur, nxt; int ui = 0;
    if (!S.next(0, cur)) return;
    LAS int* tab = (LAS int*)(lds + TAB_OFF);
    if (g.rowtab) {
        { const char* cB0 = (const char*)g.Bt + (size_t)cur.pb * (2 * (size_t)128 * g.ldb * ESZ); const size_t hB0 = (size_t)128 * g.ldb * ESZ;
#pragma unroll
          for (int hh = 0; hh < 2; ++hh)
#pragma unroll
            for (int _i = 0; _i < 2; ++_i)
                __builtin_amdgcn_global_load_lds((const unsigned*)(cB0 + hh * hB0 + voffB[_i]), (LAS unsigned*)(lds + (4 + hh) * HTB + (unsigned)wid * 1024u + _i * 8192), 16, 0, 0); }
        Unit u; int tv[5];
#pragma unroll
        for (int k2 = 0; k2 < 5; ++k2) { const int k = 2 * k2 + (tid >> 8); tv[k2] = (k < 9 && S.next(k, u)) ? g.rowtab[u.pm * 256 + (tid & 255)] : 0; }
#pragma unroll
        for (int k2 = 0; k2 < 5; ++k2) { const int k = 2 * k2 + (tid >> 8); if (k < 9) tab[k * 256 + (tid & 255)] = tv[k2]; }
        asm volatile("s_waitcnt vmcnt(0) lgkmcnt(0)" ::: "memory");
        __syncthreads();
    }
    unsigned VA[2][2];
#define GP_LOAD_VA(k_, u_) do { _Pragma("unroll") for (int _h = 0; _h < 2; ++_h) _Pragma("unroll") for (int _i = 0; _i < 2; ++_i) { const int _rr = _h * 128 + 64 * _i + (rc & 255); \
        const int _ar = g.rowtab ? tab[(k_) * 256 + _rr] : (u_).pm * 256 + _rr; VA[_h][_i] = (unsigned)((_ar * g.lda + (u_).koff) * ESZ + (rc >> 8) * 2); } } while (0)
    GP_LOAD_VA(0, cur);
    const size_t kstep = 128;
    const size_t hstepB = (size_t)128 * g.ldb * ESZ;
    const size_t tstepB = 2 * hstepB;
    const unsigned ldsw = (unsigned)wid * 1024u;
    const int aoff = lds_byte(wr * 64 + fr, fq * 8), boff = lds_byte(wc * 32 + fr, fq * 8);
#define GP_SA(b, h) (((b) * 2 + (h)) * HTB)
#define GP_SB(b, h) ((4 + (b) * 2 + (h)) * HTB)
#define GP_STG_B(bufoff, gbase) do { _Pragma("unroll") for (int _i = 0; _i < 2; ++_i) \
        __builtin_amdgcn_global_load_lds((const unsigned*)((const char*)(gbase) + voffB[_i]), (LAS unsigned*)(lds + (bufoff) + ldsw + _i * 8192), 16, 0, 0); } while (0)
#define GP_STG_A(bufoff, gbase, h) do { _Pragma("unroll") for (int _i = 0; _i < 2; ++_i) \
        __builtin_amdgcn_global_load_lds((const unsigned*)((const char*)(gbase) + VA[h][_i]), (LAS unsigned*)(lds + (bufoff) + ldsw + _i * 8192), 16, 0, 0); } while (0)
#define GP_LDA(dst, b, h) do { _Pragma("unroll") for (int m = 0; m < 4; ++m) _Pragma("unroll") for (int k = 0; k < 2; ++k) dst[m][k] = *(const LAS bf16x8*)(lds + GP_SA(b, h) + aoff + m * 2048 + k * 1024); } while (0)
#define GP_LDB(dst, b, h) do { _Pragma("unroll") for (int n = 0; n < 2; ++n) _Pragma("unroll") for (int k = 0; k < 2; ++k) dst[n][k] = *(const LAS bf16x8*)(lds + GP_SB(b, h) + boff + n * 2048 + k * 1024); } while (0)
#define GP_CAT(x) __builtin_shufflevector(__builtin_bit_cast(u32x4, (x)[0]), __builtin_bit_cast(u32x4, (x)[1]), 0, 1, 2, 3, 4, 5, 6, 7)
#define GP_MMA(ai, bj, At, Bt) do { __builtin_amdgcn_s_setprio(1); _Pragma("unroll") for (int m = 0; m < 4; ++m) _Pragma("unroll") for (int n = 0; n < 2; ++n) { \
        if constexpr (FP8) acc[ai][bj][m][n] = __builtin_amdgcn_mfma_scale_f32_16x16x128_f8f6f4(__builtin_bit_cast(v8i32, GP_CAT(Bt[n])), __builtin_bit_cast(v8i32, GP_CAT(At[m])), acc[ai][bj][m][n], 0, 0, 0, Epi::MSCALE, 0, 0x7f7f7f7f); \
        else { _Pragma("unroll") for (int k = 0; k < 2; ++k) acc[ai][bj][m][n] = __builtin_amdgcn_mfma_f32_16x16x32_bf16(Bt[n][k], At[m][k], acc[ai][bj][m][n], 0, 0, 0); } } \
        __builtin_amdgcn_s_setprio(0); } while (0)
#define GP_WAIT_V(n) asm volatile("s_waitcnt vmcnt(" #n ")" ::: "memory")
#define GP_WAIT_L(n) asm volatile("s_waitcnt lgkmcnt(" #n ")" ::: "memory")
#define GP_WAIT_LT do { if constexpr (!(FP8 && LEAD)) GP_WAIT_L(0); } while (0)
#define GP_BAR __builtin_amdgcn_s_barrier()
#define GP_SCHED __builtin_amdgcn_sched_barrier(0)
    auto body = [&](auto leadc) __attribute__((always_inline)) {
    constexpr bool LEAD = decltype(leadc)::value;
    f32x4 acc[2][2][4][2];
#pragma unroll
    for (int a = 0; a < 2; ++a)
#pragma unroll
        for (int b = 0; b < 2; ++b)
#pragma unroll
            for (int m = 0; m < 4; ++m)
#pragma unroll
                for (int n = 0; n < 2; ++n) acc[a][b][m][n] = (f32x4){0.f, 0.f, 0.f, 0.f};
    bf16x8 At[4][2], B0[2][2], B1[2][2];
    const char* A0 = (const char*)g.A;
    const char* cB = (const char*)g.Bt + (size_t)cur.pb * tstepB;
    if (!g.rowtab) { GP_STG_B(GP_SB(0, 0), cB); GP_STG_B(GP_SB(0, 1), cB + hstepB); }
    GP_STG_A(GP_SA(0, 0), A0, 0); GP_STG_A(GP_SA(0, 1), A0, 1);
    if (wr == 1) GP_BAR;
    GP_WAIT_V(2); GP_BAR;
    GP_STG_B(GP_SB(1, 0), cB + kstep); GP_STG_A(GP_SA(1, 0), A0 + kstep, 0); GP_STG_B(GP_SB(1, 1), cB + hstepB + kstep);
    GP_WAIT_V(6); GP_BAR;
    for (;;) {
        const bool has_next = S.next(ui + 1, nxt);
        const char* nB = has_next ? (const char*)g.Bt + (size_t)nxt.pb * tstepB : cB;
#pragma unroll 1
        for (int t = 0; t < nt; t += 2) {
            const bool last = (t == nt - 2);
            const char* a1 = A0 + (size_t)(t + 1) * kstep;
            const char* a2 = last ? A0 : A0 + (size_t)(t + 2) * kstep; const char* b2 = last ? nB : cB + (size_t)(t + 2) * kstep;
            const char* a3 = a2 + kstep; const char* b3 = b2 + kstep;
            if constexpr (FP8 && LEAD) { GP_LDB(B0, 0, 0); GP_SCHED; GP_LDA(At, 0, 0); } else { GP_LDB(B0, 0, 0); GP_LDB(B1, 0, 1); GP_SCHED; GP_LDA(At, 0, 0); }
            GP_STG_A(GP_SA(1, 1), a1, 1);
            if (last && has_next) GP_LOAD_VA(ui + 1, nxt);
            GP_WAIT_V(8); GP_WAIT_LT; GP_BAR;
            if constexpr (FP8 && LEAD) { GP_LDB(B1, 0, 1); GP_SCHED; GP_MMA(0, 0, At, B0); GP_MMA(0, 1, At, B1); } else { GP_MMA(0, 0, At, B0); GP_MMA(0, 1, At, B1); }
            GP_BAR; GP_SCHED;
            GP_LDA(At, 0, 1); GP_STG_B(GP_SB(0, 0), b2); GP_STG_B(GP_SB(0, 1), b2 + hstepB); GP_STG_A(GP_SA(0, 0), a2, 0);
            GP_WAIT_V(8); GP_WAIT_LT; GP_BAR; GP_MMA(1, 0, At, B0); GP_MMA(1, 1, At, B1); GP_BAR; GP_SCHED;
            if constexpr (FP8 && LEAD) { GP_LDB(B0, 1, 0); GP_SCHED; GP_LDA(At, 1, 0); } else { GP_LDB(B0, 1, 0); GP_LDB(B1, 1, 1); GP_SCHED; GP_LDA(At, 1, 0); }
            GP_STG_A(GP_SA(0, 1), a2, 1);
            GP_WAIT_V(8); GP_WAIT_LT; GP_BAR;
            if constexpr (FP8 && LEAD) { GP_LDB(B1, 1, 1); GP_SCHED; GP_MMA(0, 0, At, B0); GP_MMA(0, 1, At, B1); } else { GP_MMA(0, 0, At, B0); GP_MMA(0, 1, At, B1); }
            GP_BAR; GP_SCHED;
            GP_LDA(At, 1, 1); GP_STG_B(GP_SB(1, 0), b3); GP_STG_B(GP_SB(1, 1), b3 + hstepB); GP_STG_A(GP_SA(1, 0), a3, 0);
            GP_WAIT_V(8); GP_WAIT_LT; GP_BAR; GP_MMA(1, 0, At, B0); GP_MMA(1, 1, At, B1); GP_BAR; GP_SCHED;
        }
        if (wr == 0) GP_BAR;
        E(acc, cur, wr, wc, fr, fq);
        if (!has_next) break;
#pragma unroll
        for (int a = 0; a < 2; ++a)
#pragma unroll
            for (int b = 0; b < 2; ++b)
#pragma unroll
                for (int m = 0; m < 4; ++m)
#pragma unroll
                    for (int n = 0; n < 2; ++n) acc[a][b][m][n] = (f32x4){0.f, 0.f, 0.f, 0.f};
        cur = nxt; cB = nB; ++ui;
        if (wr == 1) GP_BAR;
    }
    GP_WAIT_V(0);
    GP_BAR;
    };
    if constexpr (FP8) { if (wr == 0) body(GpLead{}); else body(GpTrail{}); } else body(GpTrail{});
#undef GP_LOAD_VA
#undef GP_SA
#undef GP_SB
#undef GP_STG_A
#undef GP_STG_B
#undef GP_LDA
#undef GP_LDB
#undef GP_MMA
#undef GP_CAT
#undef GP_WAIT_V
#undef GP_WAIT_L
#undef GP_WAIT_LT
#undef GP_BAR
#undef GP_SCHED
}

struct EpiBf16 {
    bf16_t* O; int ldo;
    __device__ __forceinline__ void operator()(const f32x4 (&acc)[2][2][4][2], const Unit& u, int wr, int wc, int fr_, int fq_) const {
        const int lane_ = otid() & 63, fr = lane_ & 15, fq = lane_ >> 4;
#pragma unroll
        for (int ai = 0; ai < 2; ++ai)
#pragma unroll
            for (int m = 0; m < 4; ++m) {
                bf16_t* rowp = O + (size_t)(u.pm * 256 + 128 * ai + 64 * wr + 16 * m + fr) * ldo + u.pn * 256 + 32 * wc + 8 * fq;
#pragma unroll
                for (int bj = 0; bj < 2; ++bj) { const f32x4 v0 = acc[ai][bj][m][0], v1 = acc[ai][bj][m][1];
                    u32x4 w; w.x = pk2(v0[0], v0[1]); w.y = pk2(v0[2], v0[3]); w.z = pk2(v1[0], v1[1]); w.w = pk2(v1[2], v1[3]);
                    *(u32x4*)(rowp + 128 * bj) = w; }
            }
    }
};
struct EpiSwiglu {
    bf16_t* O;
    __device__ __forceinline__ void operator()(const f32x4 (&acc)[2][2][4][2], const Unit& u, int wr, int wc, int fr_, int fq_) const {
        const int lane_ = otid() & 63, fr = lane_ & 15, fq = lane_ >> 4;
#pragma unroll
        for (int ai = 0; ai < 2; ++ai)
#pragma unroll
            for (int m = 0; m < 4; ++m) {
                bf16_t* rowp = O + (size_t)(u.pm * 256 + 128 * ai + 64 * wr + 16 * m + fr) * FH + u.pn * 128 + 32 * wc + 8 * fq;
                float h[8];
#pragma unroll
                for (int n = 0; n < 2; ++n)
#pragma unroll
                    for (int r = 0; r < 4; ++r) h[4 * n + r] = siluf(acc[ai][0][m][n][r]) * acc[ai][1][m][n][r];
                u32x4 w; w.x = pk2(h[0], h[1]); w.y = pk2(h[2], h[3]); w.z = pk2(h[4], h[5]); w.w = pk2(h[6], h[7]);
                *(u32x4*)rowp = w;
            }
    }
};
struct EpiSwigluF8 {
    static constexpr int MSCALE = 0x76767676;
    unsigned char* O;
    __device__ __forceinline__ void operator()(const f32x4 (&acc)[2][2][4][2], const Unit& u, int wr, int wc, int fr_, int fq_) const {
        const int lane_ = otid() & 63, fr = lane_ & 15, fq = lane_ >> 4;
        static_assert(ACT_SCALE * W_SCALE == 512.f, "MSCALE");
        constexpr float ih = 1.f / HID_SCALE;
#pragma unroll
        for (int ai = 0; ai < 2; ++ai)
#pragma unroll
            for (int m = 0; m < 4; ++m) {
                unsigned char* rowp = O + (size_t)(u.pm * 256 + 128 * ai + 64 * wr + 16 * m + fr) * FH + u.pn * 128 + 32 * wc + 8 * fq;
                float h[8];
#pragma unroll
                for (int n = 0; n < 2; ++n) {
                    const f32x4 G = acc[ai][0][m][n], U = acc[ai][1][m][n];
                    const f32x2 g01 = (f32x2){G[0], G[1]}, g23 = (f32x2){G[2], G[3]}, u01 = (f32x2){U[0], U[1]}, u23 = (f32x2){U[2], U[3]};
                    const f32x2 t01 = g01 * (-1.44269504089f), t23 = g23 * (-1.44269504089f);
                    const f32x2 d01 = (f32x2){__builtin_amdgcn_exp2f(t01.x), __builtin_amdgcn_exp2f(t01.y)} * ih + ih;
                    const f32x2 d23 = (f32x2){__builtin_amdgcn_exp2f(t23.x), __builtin_amdgcn_exp2f(t23.y)} * ih + ih;
                    const f32x2 P = d01 * d23;
                    const float r = __builtin_amdgcn_rcpf(P.x * P.y);
                    const f32x2 q = (f32x2){P.y, P.x} * r;
                    const f32x2 h01 = (g01 * u01) * (q * d23), h23 = (g23 * u23) * (q * d01);
                    h[4 * n] = h01.x; h[4 * n + 1] = h01.y; h[4 * n + 2] = h23.x; h[4 * n + 3] = h23.y; }
                u32x2 w; w.x = pk4_fp8(h[0], h[1], h[2], h[3]); w.y = pk4_fp8(h[4], h[5], h[6], h[7]);
                *(u32x2*)rowp = w;
            }
    }
};
constexpr float YS_SCALE = 8.f;
struct EpiYsF8 {
    static constexpr int MSCALE = 0x79797979;
    unsigned char* O;
    __device__ __forceinline__ void operator()(const f32x4 (&acc)[2][2][4][2], const Unit& u, int wr, int wc, int fr_, int fq_) const {
        const int lane_ = otid() & 63, fr = lane_ & 15, fq = lane_ >> 4;
        static_assert(YS_SCALE * 64.f == HID_SCALE * W_SCALE, "MSCALE");
#pragma unroll
        for (int ai = 0; ai < 2; ++ai)
#pragma unroll
            for (int m = 0; m < 4; ++m) {
                unsigned char* rowp = O + (size_t)(u.pm * 256 + 128 * ai + 64 * wr + 16 * m + fr) * D + u.pn * 256 + 32 * wc + 8 * fq;
#pragma unroll
                for (int bj = 0; bj < 2; ++bj) { const f32x4 v0 = acc[ai][bj][m][0], v1 = acc[ai][bj][m][1];
                    u32x2 w; w.x = pk4_fp8(v0[0], v0[1], v0[2], v0[3]); w.y = pk4_fp8(v1[0], v1[1], v1[2], v1[3]);
                    *(u32x2*)(rowp + 128 * bj) = w; }
            }
    }
};
template <bool BASE_BF16>
struct EpiResid {
    static constexpr int MSCALE = 0x76767676;
    const void* base_x; const void* base_c; bf16_t* out; const float* gate  ; const float* scale;
    __device__ __forceinline__ void operator()(const f32x4 (&acc)[2][2][4][2], const Unit& u, int wr, int wc, int fr_, int fq_) const {
        const int lane_ = otid() & 63, fr = lane_ & 15, fq = lane_ >> 4;
        const int modrow = u.pm < 64 ? (u.pm >> 3) : 8;
        const size_t brow0 = u.pm < 64 ? (size_t)u.pm * 256 : (size_t)(u.pm - 64) * 256;
        const void* basep = u.pm < 64 ? base_x : base_c;
        const int colb = u.pn * 256 + 32 * wc + 8 * fq;
        f32x4 g[2][2];
#pragma unroll
        for (int bj = 0; bj < 2; ++bj) { const int col = colb + 128 * bj;
            g[bj][0] = *(const f32x4*)(gate + (size_t)modrow * NADA + col); g[bj][1] = *(const f32x4*)(gate + (size_t)modrow * NADA + col + 4);
            if (scale) { g[bj][0] = g[bj][0] * *(const f32x4*)(scale + col); g[bj][1] = g[bj][1] * *(const f32x4*)(scale + col + 4); } }
#pragma unroll
        for (int ai = 0; ai < 2; ++ai) {
            if constexpr (BASE_BF16) {
                u32x4 bw[4][2];
#pragma unroll
                for (int m = 0; m < 4; ++m)
#pragma unroll
                    for (int bj = 0; bj < 2; ++bj) bw[m][bj] = __builtin_nontemporal_load((const u32x4*)((const bf16_t*)basep + (brow0 + 128 * ai + 64 * wr + 16 * m + fr) * D + colb + 128 * bj));
#pragma unroll
                for (int m = 0; m < 4; ++m)
#pragma unroll
                    for (int bj = 0; bj < 2; ++bj) { const u32x4 w = bw[m][bj]; const int r = 128 * ai + 64 * wr + 16 * m + fr;
                        const f32x2 a0 = unr(w.x), a1 = unr(w.y), a2 = unr(w.z), a3 = unr(w.w);
                        const f32x4 o0 = (f32x4){a0.x, a0.y, a1.x, a1.y} + g[bj][0] * acc[ai][bj][m][0], o1 = (f32x4){a2.x, a2.y, a3.x, a3.y} + g[bj][1] * acc[ai][bj][m][1];
                        u32x4 ow; ow.x = pkr(o0.x, o0.y); ow.y = pkr(o0.z, o0.w); ow.z = pkr(o1.x, o1.y); ow.w = pkr(o1.z, o1.w);
                        *(u32x4*)(out + (size_t)(u.pm * 256 + r) * D + colb + 128 * bj) = ow; }
            } else {
#pragma unroll
                for (int mh = 0; mh < 2; ++mh) {
                    f32x4 bv[2][2][2];
#pragma unroll
                    for (int m2 = 0; m2 < 2; ++m2)
#pragma unroll
                        for (int bj = 0; bj < 2; ++bj) { const float* bp = (const float*)basep + (brow0 + 128 * ai + 64 * wr + 16 * (2 * mh + m2) + fr) * D + colb + 128 * bj;
                            bv[m2][bj][0] = __builtin_nontemporal_load((const f32x4*)bp); bv[m2][bj][1] = __builtin_nontemporal_load((const f32x4*)(bp + 4)); }
#pragma unroll
                    for (int m2 = 0; m2 < 2; ++m2)
#pragma unroll
                        for (int bj = 0; bj < 2; ++bj) { const int m = 2 * mh + m2, r = 128 * ai + 64 * wr + 16 * m + fr;
                            const f32x4 o0 = bv[m2][bj][0] + g[bj][0] * acc[ai][bj][m][0], o1 = bv[m2][bj][1] + g[bj][1] * acc[ai][bj][m][1];
                            u32x4 ow; ow.x = pkr(o0.x, o0.y); ow.y = pkr(o0.z, o0.w); ow.z = pkr(o1.x, o1.y); ow.w = pkr(o1.z, o1.w);
                            *(u32x4*)(out + (size_t)(u.pm * 256 + r) * D + colb + 128 * bj) = ow; }
                    asm volatile("" ::: "memory");
                }
            }
            asm volatile("" ::: "memory");
        }
    }
};
struct EpiInproj {
    bf16_t* P; float* gates; const float* bias;
    __device__ __forceinline__ void operator()(const f32x4 (&acc)[2][2][4][2], const Unit& u, int wr, int wc, int fr_, int fq_) const {
        const int lane_ = otid() & 63, fr = lane_ & 15, fq = lane_ >> 4;
        if (u.pn < 12) {
            const float sc = u.pn < 2 ? 0.125f : 1.f;
#pragma unroll
            for (int ai = 0; ai < 2; ++ai)
#pragma unroll
                for (int m = 0; m < 4; ++m) {
                    bf16_t* rowp = P + (size_t)(u.pm * 256 + 128 * ai + 64 * wr + 16 * m + fr) * NQKVO + u.pn * 256 + 32 * wc + 8 * fq;
#pragma unroll
                    for (int bj = 0; bj < 2; ++bj) { const f32x4 v0 = acc[ai][bj][m][0] * sc, v1 = acc[ai][bj][m][1] * sc;
                        u32x4 w; w.x = pk2(v0[0], v0[1]); w.y = pk2(v0[2], v0[3]); w.z = pk2(v1[0], v1[1]); w.w = pk2(v1[2], v1[3]);
                        *(u32x4*)(rowp + 128 * bj) = w; }
                }
        } else if (wc == 0) {
            const f32x4 b0 = *(const f32x4*)(bias + 8 * fq), b1 = *(const f32x4*)(bias + 8 * fq + 4);
#pragma unroll
            for (int ai = 0; ai < 2; ++ai)
#pragma unroll
                for (int m = 0; m < 4; ++m) {
                    float* rowp = gates + (size_t)(u.pm * 256 + 128 * ai + 64 * wr + 16 * m + fr) * 32 + 8 * fq;
                    *(f32x4*)rowp = acc[ai][0][m][0] + b0; *(f32x4*)(rowp + 4) = acc[ai][0][m][1] + b1;
                }
        }
    }
};

__device__ __forceinline__ int vcu_of_block() { const int G = gridDim.x, bx = blockIdx.x; return (G % 8 == 0) ? (bx % 8) * (G / 8) + bx / 8 : bx; }
struct SchedGrid {
    int nM, nN, G, c, koff_per_pn, pb_per_pn;
    __device__ __forceinline__ bool next(int i, Unit& u) const {
        const int L = i * G + c; if (L >= nM * nN) return false;
        const int nig = 8 * nN, gid = L / nig, fm = gid * 8, gsz = (nM - fm) < 8 ? (nM - fm) : 8, w = L % nig;
        u.pm = fm + (w % gsz); u.pn = w / gsz; u.pb = u.pn * pb_per_pn; u.koff = u.pn * koff_per_pn; return true;
    }
};
struct SchedMoe {
    int nmu, nN, G, c, wbase  ;
    __device__ __forceinline__ bool next(int i, Unit& u) const {
        const int L = i * G + c; if (L >= nmu * nN) return false;
        const int grp = L >> 5, j = L & 31, ngn = nN / 4, mb = grp / ngn, nq = grp % ngn;
        u.pm = mb * 8 + (j & 7); u.pn = nq * 4 + (j >> 3);
        const int e = u.pm < 128 ? (u.pm >> 3) : (u.pm - 128);
        u.pb = wbase + e * nN + u.pn; u.koff = 0; return true;
    }
};

struct SchedInproj {
    static constexpr bool BKOFF = false;
    int G, c;
    __device__ __forceinline__ bool next(int i, Unit& u) const {
        const int L = i * G + c; if (L >= 832 + 56) return false;
        if (L < 832) { const int nig = 8 * 13, gid = L / nig, w = L % nig; u.pm = gid * 8 + (w & 7); u.pn = w >> 3; }
        else { const int idx = L - 832, q = idx % 7; u.pm = 64 + idx / 7; u.pn = q < 6 ? 2 + q : 12; }
        u.pb = u.pn; u.koff = 0; return true;
    }
};
__device__ __forceinline__ void transpose_item(const float* W, int K, int N, bf16_t* WT, int drow0, LAS float* scr, int kb, int nb, int lane) {
    const int k0 = 64 * kb, n0 = 32 * nb;
#pragma unroll 8
    for (int i = 0; i < 32; ++i) { const int kk = 2 * i + (lane >> 5); const int n = n0 + (lane & 31); scr[kk * 33 + (lane & 31)] = (n < N) ? __builtin_nontemporal_load(W + (size_t)(k0 + kk) * N + n) : 0.f; }
    asm volatile("s_waitcnt lgkmcnt(0)" ::: "memory");
    const int cc = lane & 7;
#pragma unroll
    for (int j = 0; j < 4; ++j) { const int n = (lane >> 3) + 8 * j; const LAS float* s = scr + (8 * cc) * 33 + n;
        u32x4 o; o.x = pk2(s[0 * 33], s[1 * 33]); o.y = pk2(s[2 * 33], s[3 * 33]); o.z = pk2(s[4 * 33], s[5 * 33]); o.w = pk2(s[6 * 33], s[7 * 33]);
        *(u32x4*)(WT + (size_t)(drow0 + n) * K + k0 + 8 * cc) = o; }
    asm volatile("s_waitcnt lgkmcnt(0)" ::: "memory");
}

struct F8Item { const float* src; unsigned char* dst; int N, K; };
__device__ __forceinline__ F8Item f8_item(const Params& P, int r, int lane) {
    unsigned char* ws = P.ws;
    const int le = r / 1536, q = r % 1536, kind = q >> 9, idx = q & 511;
    F8Item it;
    if (kind < 2) { const int kb = idx >> 6, nb = idx & 63, n0 = nb * 32; it.N = FH; it.K = D;
        it.src = (kind ? P.w_up : P.w_gate) + (size_t)le * D * FH + (size_t)(128 * kb + (lane >> 3)) * FH + n0 + 4 * (lane & 7);
        it.dst = (unsigned char*)(ws + WS_WGUT) + (size_t)le * 4096 * D + (size_t)((n0 >> 7) * 256 + kind * 128 + (n0 & 127)) * D + 128 * kb; }
    else { const int kb = idx >> 5, nb = idx & 31, n0 = nb * 32; it.N = D; it.K = FH;
        it.src = P.w_down + (size_t)le * FH * D + (size_t)(128 * kb + (lane >> 3)) * D + n0 + 4 * (lane & 7);
        it.dst = (unsigned char*)(ws + WS_WDT) + (size_t)le * D * FH + (size_t)n0 * FH + 128 * kb; }
    return it;
}
__device__ __forceinline__ void f8_load(const F8Item& it, f32x4 (&wv)[16]) {
#pragma unroll
    for (int i = 0; i < 16; ++i) wv[i] = __builtin_nontemporal_load((const f32x4*)(it.src + (size_t)(8 * i) * it.N));
}
template <bool STORE = true>
__device__ __forceinline__ void f8_finish(const F8Item& it, const f32x4 (&wv)[16], LAS float* scr, int lane) {
#pragma unroll
    for (int i = 0; i < 16; ++i) { LAS float* d = scr + (8 * i + (lane >> 3)) * 33 + 4 * (lane & 7); d[0] = wv[i].x; d[1] = wv[i].y; d[2] = wv[i].z; d[3] = wv[i].w; }
    asm volatile("s_waitcnt lgkmcnt(0)" ::: "memory");
    const int cc = lane & 7;
#pragma unroll
    for (int j = 0; j < 4; ++j) { const int n = (lane >> 3) + 8 * j; const LAS float* sp = scr + (16 * cc) * 33 + n;
        u32x4 o;
        o.x = pk4_fp8(sp[0 * 33] * W_SCALE, sp[1 * 33] * W_SCALE, sp[2 * 33] * W_SCALE, sp[3 * 33] * W_SCALE);
        o.y = pk4_fp8(sp[4 * 33] * W_SCALE, sp[5 * 33] * W_SCALE, sp[6 * 33] * W_SCALE, sp[7 * 33] * W_SCALE);
        o.z = pk4_fp8(sp[8 * 33] * W_SCALE, sp[9 * 33] * W_SCALE, sp[10 * 33] * W_SCALE, sp[11 * 33] * W_SCALE);
        o.w = pk4_fp8(sp[12 * 33] * W_SCALE, sp[13 * 33] * W_SCALE, sp[14 * 33] * W_SCALE, sp[15 * 33] * W_SCALE);
        if constexpr (STORE) *(u32x4*)(it.dst + (size_t)n * it.K + 16 * cc) = o; else asm volatile("" :: "v"(o)); }
    asm volatile("s_waitcnt lgkmcnt(0)" ::: "memory");
}

constexpr int F8_L0_ITEMS = NE * 1536, F8_TOTAL = 2 * NE * 1536;
constexpr int F8_N1 = 128 * 8 * 6;
constexpr int F8_N2 = 192 * 8 * 8;
constexpr int F8_N3 = 136 * 8 * 6;
constexpr int F8_N5 = 192 * 8 * 1;
constexpr int F8_N4 = 128 * 8 * 4;
constexpr int F8_DEFERRED = F8_N1 + F8_N2 + F8_N3 + F8_N5 + F8_N4, F8_SKIP = F8_TOTAL - F8_DEFERRED;
constexpr int F8_S1 = F8_SKIP, F8_S2 = F8_S1 + F8_N1, F8_S3 = F8_S2 + F8_N2, F8_S5 = F8_S3 + F8_N3, F8_S4 = F8_S5 + F8_N5;
static_assert(F8_S4 + F8_N4 == F8_TOTAL && F8_S2 >= F8_L0_ITEMS && F8_SKIP > 0, "deferred slices: layer-0 items only in the slice that runs before the layer-0 expert GEMMs");
__device__ __forceinline__ void f8_convert_range(const Params& P, LAS unsigned char* lds, int first, int count, int w, int nworkers, int skip_at, int skip_len) {
    const int tid = otid(), lane = tid & 63, wave = __builtin_amdgcn_readfirstlane(tid >> 6);
    LAS float* scr = (LAS float*)(lds + wave * 17408);
    const int end = first + count; int it = first + w;
    if (it < end) {
        F8Item cur = f8_item(P, it < skip_at ? it : it + skip_len, lane); f32x4 wv[16]; f8_load(cur, wv);
        for (; it < end; it += nworkers) {
            const int nx = it + nworkers; F8Item nxt = cur; f32x4 wn[16];
            if (nx < end) { nxt = f8_item(P, nx < skip_at ? nx : nx + skip_len, lane); f8_load(nxt, wn); }
            f8_finish(cur, wv, scr, lane);
            if (nx < end) {
#pragma unroll
                for (int i = 0; i < 16; ++i) wv[i] = wn[i];
                cur = nxt; }
        }
    }
}

__device__ __forceinline__ void phase0(const Params& P, LAS unsigned char* lds) {
    const int tid = otid(), lane = tid & 63, wave = __builtin_amdgcn_readfirstlane(tid >> 6), G = gridDim.x;
    unsigned char* ws = P.ws;
    {
        LAS float* sv = (LAS float*)lds;
        LAS float* red = sv + 9 * 1024;
        float* mod = (float*)(ws + WS_MOD);
        bool filled = false;
        for (int it = blockIdx.x; it < 192; it += G) {
            if (!filled) {
                { float cv[18];
#pragma unroll
                  for (int q = 0; q < 18; ++q) { const int i = tid + NTHR * q, r = i >> 10, k = i & 1023; cv[q] = r < 8 ? P.c[r * D + k] : P.c_ctx[k]; }
#pragma unroll
                  for (int q = 0; q < 18; ++q) sv[tid + NTHR * q] = siluf(cv[q]); }
                filled = true; __syncthreads();
            }
            const int l = it / 96, n = (it % 96) * 64 + lane;
            const float* w = P.ada_w + (size_t)l * D * NADA + n;
            float a[9];
#pragma unroll
            for (int r = 0; r < 9; ++r) a[r] = 0.f;
#pragma unroll 8
            for (int kk = 0; kk < 128; ++kk) { const int k = wave * 128 + kk; const float wv = __builtin_nontemporal_load(w + (size_t)k * NADA);
#pragma unroll
                for (int r = 0; r < 9; ++r) a[r] += sv[r * 1024 + k] * wv; }
#pragma unroll
            for (int r = 0; r < 9; ++r) red[(wave * 9 + r) * 64 + lane] = a[r];
            __syncthreads();
            for (int i = tid; i < 9 * 64; i += NTHR) { const int r = i >> 6, nn = i & 63; float s = 0.f;
#pragma unroll
                for (int w8 = 0; w8 < 8; ++w8) s += red[(w8 * 9 + r) * 64 + nn];
                const int ncol = (it % 96) * 64 + nn;
                mod[((size_t)l * 9 + r) * NADA + ncol] = s + P.ada_b[l * NADA + ncol]; }
            __syncthreads();
        }
        __syncthreads();
    }
    const int gw = vcu_of_block() * 8 + wave, NGW = G * 8;
    {
        float* rs = (float*)(ws + WS_RSX);
        for (int m = gw; m < NCX; m += NGW) { const f32x4* xr = (const f32x4*)(P.ctx + (size_t)m * D) + lane; float s = 0.f;
#pragma unroll
            for (int j = 0; j < 4; ++j) { const f32x4 v = xr[64 * j]; s += (v.x * v.x + v.y * v.y) + (v.z * v.z + v.w * v.w); }
            s = wave_sum(s); if (lane == 0) rs[NX + m] = rsqrtf(s * (1.f / D) + EPS); }
    }
    {
        u32x4* z = (u32x4*)(ws + WS_WINT + (size_t)NIN * D * 2); const int n16 = (NINP - NIN) * D * 2 / 16;
        for (int i = blockIdx.x * NTHR + tid; i < n16; i += G * NTHR) z[i] = (u32x4){0u, 0u, 0u, 0u};
    }
    {
        LAS float* scr = (LAS float*)(lds + wave * 17408);
        constexpr int I_MOE = 2 * NE * 1536, I_IN = 16 * 97, I_OUT = 8 * 32, I_POOL = 4 * 4 * 8;
        f8_convert_range(P, lds, 0, (G == 256) ? F8_SKIP : F8_TOTAL, gw, NGW, 1 << 30, 0);
        for (int it = gw; it < I_IN + I_OUT + I_POOL; it += NGW) {
            int r = it;
            if (r < I_IN) { const int kb = r / 97, nb = r % 97; transpose_item(P.w_in, D, NIN, (bf16_t*)(ws + WS_WINT), nb * 32, scr, kb, nb, lane); continue; }
            r -= I_IN;
            if (r < I_OUT) { const int kb = r >> 5, nb = r & 31;
                F8Item itw; itw.N = D; itw.K = D; itw.src = P.w_out + (size_t)(128 * kb + (lane >> 3)) * D + nb * 32 + 4 * (lane & 7); itw.dst = (unsigned char*)(ws + WS_WOUTT) + (size_t)(nb * 32) * D + 128 * kb;
                f32x4 wv[16]; f8_load(itw, wv); f8_finish(itw, wv, scr, lane); continue; }
            r -= I_OUT;
            { const int j = r >> 5, q = r & 31, kb = q >> 3, nb = q & 7; transpose_item(P.pool_w + (size_t)j * 256 * 256, 256, 256, (bf16_t*)(ws + WS_POOLWT) + (size_t)j * 256 * 256, nb * 32, scr, kb, nb, lane); }
        }
    }
}


#ifndef PROBE_P0R
#define PROBE_P0R 0
#endif
__device__ __forceinline__ void probe_p0_readonly(const Params& P, LAS unsigned char* lds) {
    const int tid = otid(), lane = tid & 63, wave = __builtin_amdgcn_readfirstlane(tid >> 6), G = gridDim.x;
    const int gw = vcu_of_block() * 8 + wave, NGW = G * 8;
    LAS float* scr = (LAS float*)(lds + wave * 17408);
    constexpr int I_MOE = 2 * NE * 1536;
    if (gw < I_MOE) {
        F8Item cur = f8_item(P, gw, lane); f32x4 wv[16]; f8_load(cur, wv);
        for (int it = gw; it < I_MOE; it += NGW) {
            const int nx = it + NGW; F8Item nxt = cur; f32x4 wn[16];
            if (nx < I_MOE) { nxt = f8_item(P, nx, lane); f8_load(nxt, wn); }
            f8_finish<false>(cur, wv, scr, lane);
            if (nx < I_MOE) {
#pragma unroll
                for (int i = 0; i < 16; ++i) wv[i] = wn[i];
                cur = nxt; }
        }
    }
}
template <int W>
__device__ __forceinline__ void hslide64(const f32x2 (&z)[64], bf16_t* outp  ) {
    constexpr int HW = W / 2;
    f32x2 s = (f32x2){0.f, 0.f};
#pragma unroll
    for (int c = 0; c < HW; ++c) s += z[c];
#pragma unroll
    for (int c = 0; c < 64; ++c) {
        const int lo = c - HW < 0 ? 0 : c - HW, hi = c + HW > 64 ? 64 : c + HW;
        const float inv = 1.f / (float)(hi - lo);
        { const f32x2 hm = s * inv; *(unsigned*)(outp + (size_t)c * D) = pk2(hm.x, hm.y); }
        if (c + HW < 64) s += z[c + HW];
        if (c - HW >= 0) s -= z[c - HW];
    }
}
template <int W>
__device__ __forceinline__ void cslide32(const f32x2 (&zc)[48], int t0, f32x2 Gc, bf16_t* ap  ) {
    constexpr int HW = W / 2;
    f32x2 s = (f32x2){0.f, 0.f};
#pragma unroll
    for (int i = 8 - HW; i < 8 + HW; ++i) s += zc[i];
#pragma unroll
    for (int k = 0; k < 32; ++k) {
        const int t = t0 + k, lo = t - HW < 0 ? 0 : t - HW, hi = t + HW > TC ? TC : t + HW;
        const f32x2 df = (s * (1.f / (float)(hi - lo)) - zc[8 + k]) * Gc;
        *(unsigned*)(ap + (size_t)k * D) = pk2(df.x, df.y);
        s += zc[8 + k + HW]; s -= zc[8 + k - HW];
    }
}
__device__ __forceinline__ void phase1(const Params& P, LAS unsigned char* lds) {
    const int tid = otid(), lane = tid & 63, wave = __builtin_amdgcn_readfirstlane(tid >> 6), G = gridDim.x;
    unsigned char* ws = P.ws;
    float* rs = (float*)(ws + WS_RSX); bf16_t* Hb = (bf16_t*)(ws + WS_BIG);
    LAS float* red = (LAS float*)lds;
    LAS float* rr = red + 512;
    const int d0 = 2 * tid, grp = tid >> 7;
    for (int it = blockIdx.x; it < NB * 32; it += G) {
        const int tok0 = it * 64;
        const float* xp = P.x + (size_t)tok0 * D + d0;
        f32x2 z[64]; float ss[64];
#pragma unroll
        for (int c = 0; c < 64; ++c) { z[c] = __builtin_nontemporal_load((const f32x2*)(xp + (size_t)c * D)); ss[c] = z[c].x * z[c].x + z[c].y * z[c].y; }
        { bf16_t* xh = (bf16_t*)(ws + WS_XB) + (size_t)tok0 * D + d0;
#pragma unroll
          for (int c = 0; c < 64; ++c) *(unsigned*)(xh + (size_t)c * D) = pkr(z[c].x, z[c].y); }
#pragma unroll
        for (int off = 32; off >= 1; off >>= 1) {
            const bool up = (lane & off) != 0;
#pragma unroll
            for (int i = 0; i < off; ++i) { const float keep = up ? ss[i + off] : ss[i], send = up ? ss[i] : ss[i + off]; ss[i] = keep + __shfl_xor(send, off); }
        }
        red[wave * 64 + lane] = ss[0];
        __syncthreads();
        if (tid < 64) { float s = 0.f;
#pragma unroll
            for (int w8 = 0; w8 < 8; ++w8) s += red[w8 * 64 + tid];
            const float r = rsqrtf(s * (1.f / D) + EPS); rr[tid] = r; rs[tok0 + tid] = r; }
        __syncthreads();
#pragma unroll
        for (int c = 0; c < 64; ++c) z[c] = z[c] * rr[c];
        bf16_t* outp = Hb + (size_t)tok0 * D + d0;
        switch (grp) { case 0: hslide64<2>(z, outp); break; case 1: hslide64<4>(z, outp); break; case 2: hslide64<8>(z, outp); break; default: hslide64<16>(z, outp); break; }
        __syncthreads();
    }
}
__device__ __forceinline__ void ctx_pool(const Params& P) {
    const int tid = otid(); unsigned char* ws = P.ws; const float* rs = (const float*)(ws + WS_RSX); const int d0 = 2 * tid, grp = tid >> 7;
    if (blockIdx.x < 64) {
        const float* mod0 = (const float*)(ws + WS_MOD) + (size_t)8 * NADA;
        bf16_t* A = (bf16_t*)(ws + WS_ABF);
        const f32x2 nm = *(const f32x2*)(P.norm_mix + d0), sc = *(const f32x2*)(mod0 + D + d0);
        const f32x2 Gc = nm * (sc + 1.f);
        const int it = blockIdx.x, b = it >> 3, t0 = (it & 7) * 32;
        f32x2 zc[48];
#pragma unroll
        for (int i = 0; i < 48; ++i) { const int t = t0 - 8 + i; const bool ok = (t >= 0 && t < TC); const int tt = ok ? t : t0;
            const f32x2 xv = *(const f32x2*)(P.ctx + (size_t)(b * TC + tt) * D + d0); const float rv = rs[NX + b * TC + tt];
            zc[i] = ok ? xv * rv : (f32x2){0.f, 0.f}; }
        bf16_t* ap = A + (size_t)(NX + b * TC + t0) * D + d0;
        switch (grp) { case 0: cslide32<2>(zc, t0, Gc, ap); break; case 1: cslide32<4>(zc, t0, Gc, ap); break; case 2: cslide32<8>(zc, t0, Gc, ap); break; default: cslide32<16>(zc, t0, Gc, ap); break; }
    }
}

__device__ __forceinline__ void pool_ctx_subtiles(const Params& P, bf16_t* XA16) {
    const int tid = otid(), lane = tid & 63, wave = __builtin_amdgcn_readfirstlane(tid >> 6), fr = lane & 15, fq = lane >> 4;
    unsigned char* ws = P.ws;
    const bf16_t* A = (const bf16_t*)(ws + WS_ABF); const bf16_t* Wt = (const bf16_t*)(ws + WS_POOLWT);
    const float* gate = (const float*)(ws + WS_MOD) + (size_t)8 * NADA + 2 * D;
    for (int su = vcu_of_block(); su < 256; su += gridDim.x) {
        const int rb = su >> 2, j = su & 3;
        bf16x8 Af[2][8], Bf[2][8];
#pragma unroll
        for (int rt = 0; rt < 2; ++rt)
#pragma unroll
            for (int ks = 0; ks < 8; ++ks) Af[rt][ks] = *(const bf16x8*)(A + (size_t)(NX + 32 * rb + 16 * rt + fr) * D + 256 * j + 32 * ks + 8 * fq);
#pragma unroll
        for (int nt = 0; nt < 2; ++nt)
#pragma unroll
            for (int ks = 0; ks < 8; ++ks) Bf[nt][ks] = *(const bf16x8*)(Wt + (size_t)(j * 256 + 32 * wave + 16 * nt + fr) * 256 + 32 * ks + 8 * fq);
        f32x4 acc[2][2];
#pragma unroll
        for (int rt = 0; rt < 2; ++rt)
#pragma unroll
            for (int nt = 0; nt < 2; ++nt) { acc[rt][nt] = (f32x4){0.f, 0.f, 0.f, 0.f};
#pragma unroll
                for (int ks = 0; ks < 8; ++ks) acc[rt][nt] = __builtin_amdgcn_mfma_f32_16x16x32_bf16(Bf[nt][ks], Af[rt][ks], acc[rt][nt], 0, 0, 0); }
#pragma unroll
        for (int nt = 0; nt < 2; ++nt) { const int col = 256 * j + 32 * wave + 16 * nt + 4 * fq;
            const f32x4 gv = *(const f32x4*)(gate + col) * *(const f32x4*)(P.pool_scale + col);
#pragma unroll
            for (int rt = 0; rt < 2; ++rt) { const int r = 32 * rb + 16 * rt + fr;
                const f32x4 o = *(const f32x4*)(P.ctx + (size_t)r * D + col) + gv * acc[rt][nt];
                u32x2 w; w.x = pkr(o.x, o.y); w.y = pkr(o.z, o.w);
                *(u32x2*)(XA16 + (size_t)(NX + r) * D + col) = w; } }
    }
}

template <int W>
__device__ __forceinline__ void vslide32(const f32x2 (&hv)[32], const f32x2 (&zv)[32], f32x2 Gm, bf16_t* acol) {
    constexpr int HW = W / 2;
    f32x2 s = (f32x2){0.f, 0.f};
#pragma unroll
    for (int r = 0; r < HW; ++r) s += hv[r];
#pragma unroll
    for (int r = 0; r < 32; ++r) {
        const int lo = r - HW < 0 ? 0 : r - HW, hi = r + HW > 32 ? 32 : r + HW;
        const float inv = 1.f / (float)(hi - lo);
        const f32x2 df = (s * inv - zv[r]) * Gm;
        *(unsigned*)(acol + (size_t)r * 64 * D) = pk2(df.x, df.y);
        if (r + HW < 32) s += hv[r + HW];
        if (r - HW >= 0) s -= hv[r - HW];
    }
}
__device__ __forceinline__ void phase2(const Params& P, LAS unsigned char* lds) {
    const int tid = otid(), G = gridDim.x;
    unsigned char* ws = P.ws;
    const float* rs = (const float*)(ws + WS_RSX); const bf16_t* Hb = (const bf16_t*)(ws + WS_BIG); bf16_t* A = (bf16_t*)(ws + WS_ABF);
    const int d0 = 2 * tid, grp = tid >> 7;
    const f32x2 nm = *(const f32x2*)(P.norm_mix + d0);
    for (int it = blockIdx.x; it < NB * 64; it += G) {
        const int b = it >> 6, c = it & 63, tok0 = b * T + c;
        const f32x2 sc = *(const f32x2*)((const float*)(ws + WS_MOD) + (size_t)b * NADA + D + d0);
        const f32x2 Gm = nm * (sc + 1.f);
        f32x2 hv[32];
#pragma unroll
        for (int r = 0; r < 32; ++r) { const unsigned w = __builtin_nontemporal_load((const unsigned*)(Hb + (size_t)(tok0 + r * 64) * D + d0)); hv[r] = (f32x2){__builtin_bit_cast(float, w << 16), __builtin_bit_cast(float, w & 0xffff0000u)}; }
        const bf16_t* xcol = (const bf16_t*)(ws + WS_XB) + (size_t)tok0 * D + d0; bf16_t* acol = A + (size_t)tok0 * D + d0; const float* rsc = rs + tok0;
        f32x2 zv[32];
#pragma unroll
        for (int r = 0; r < 32; ++r) zv[r] = unr(*(const unsigned*)(xcol + (size_t)r * 64 * D)) * rsc[r * 64];
        switch (grp) { case 0: vslide32<2>(hv, zv, Gm, acol); break; case 1: vslide32<4>(hv, zv, Gm, acol); break; case 2: vslide32<8>(hv, zv, Gm, acol); break; default: vslide32<16>(hv, zv, Gm, acol); break; }
    }
}

constexpr int WTP = 1028;
template <bool ROUTER, bool OUTF8>
__device__ __forceinline__ void norm_rows(LAS unsigned char* lds, const float* xin, int nrows, const float* g, const float* modl  , int sh_chunk, bf16_t* A, const float* router  , float* aff) {
    const int tid = otid(), lane = tid & 63, wave = __builtin_amdgcn_readfirstlane(tid >> 6);
    const int gw = vcu_of_block() * 8 + wave, NGW = gridDim.x * 8;
    LAS float* wT = (LAS float*)lds;
    if constexpr (ROUTER) {
        float wt[32];
#pragma unroll
        for (int i = 0; i < 32; ++i) wt[i] = router[tid + NTHR * i];
#pragma unroll
        for (int i = 0; i < 32; ++i) { const int k = tid + NTHR * i; wT[(k & 15) * WTP + (k >> 4)] = wt[i]; }
        __syncthreads();
    }
    const int per = (nrows + NGW - 1) / NGW, mbeg = gw * per, mend = (mbeg + per < nrows) ? mbeg + per : nrows;
    f32x4 xn[4], gs[4], sh4[4]; int curmod = -1;
    if (mbeg < mend) { const f32x4* xr = (const f32x4*)(xin + (size_t)mbeg * D) + lane;
#pragma unroll
        for (int j = 0; j < 4; ++j) xn[j] = xr[64 * j]; }
    for (int m = mbeg; m < mend; ++m) {
        const int modrow = m < NX ? m / T : 8;
        f32x4 v[4]; float s = 0.f;
#pragma unroll
        for (int j = 0; j < 4; ++j) { v[j] = xn[j]; s += (v[j].x * v[j].x + v[j].y * v[j].y) + (v[j].z * v[j].z + v[j].w * v[j].w); }
        if (m + 1 < mend) { const f32x4* xr = (const f32x4*)(xin + (size_t)(m + 1) * D) + lane;
#pragma unroll
            for (int j = 0; j < 4; ++j) xn[j] = xr[64 * j]; }
        if (modrow != curmod) { curmod = modrow; const float* shp = modl + (size_t)modrow * NADA + sh_chunk * D; const float* scp = shp + D;
#pragma unroll
            for (int j = 0; j < 4; ++j) { const int e = 4 * lane + 256 * j; gs[j] = *(const f32x4*)(g + e) * (*(const f32x4*)(scp + e) + 1.f); sh4[j] = *(const f32x4*)(shp + e); } }
        const float r = rsqrtf(wave_sum(s) * (1.f / D) + EPS);
#pragma unroll
        for (int j = 0; j < 4; ++j) { const int e = 4 * lane + 256 * j;
            v[j] = v[j] * r * gs[j] + sh4[j];
            if constexpr (OUTF8) *(unsigned*)((unsigned char*)A + (size_t)m * D + e) = pk4_fp8(v[j].x * ACT_SCALE, v[j].y * ACT_SCALE, v[j].z * ACT_SCALE, v[j].w * ACT_SCALE);
            else { u32x2 w; w.x = pk2(v[j].x, v[j].y); w.y = pk2(v[j].z, v[j].w); *(u32x2*)(A + (size_t)m * D + e) = w; } }
        if constexpr (ROUTER) {
            float lg[16];
#pragma unroll
            for (int e = 0; e < 16; ++e) { float a = 0.f;
#pragma unroll
                for (int j = 0; j < 4; ++j) { const f32x4 wv = *(const LAS f32x4*)(wT + e * WTP + 4 * lane + 256 * j); a += (v[j].x * wv.x + v[j].y * wv.y) + (v[j].z * wv.z + v[j].w * wv.w); }
                lg[e] = a;
                if ((e & 3) == 3) asm volatile("" ::: "memory"); }
#pragma unroll
            for (int st = 0; st < 4; ++st) { const int off = 32 >> st, cnt = 8 >> st; const bool up = (lane & off) != 0;
#pragma unroll
                for (int i = 0; i < cnt; ++i) { const float keep = up ? lg[i + cnt] : lg[i], send = up ? lg[i] : lg[i + cnt]; lg[i] = keep + __shfl_xor(send, off); } }
            float l0 = lg[0]; l0 += __shfl_xor(l0, 2); l0 += __shfl_xor(l0, 1);
            float mx = l0;
#pragma unroll
            for (int off = 4; off < 64; off <<= 1) mx = fmaxf(mx, __shfl_xor(mx, off));
            const float ex = __expf(l0 - mx); float den = ex;
#pragma unroll
            for (int off = 4; off < 64; off <<= 1) den += __shfl_xor(den, off);
            const int l2 = otid() & 63;
            if ((l2 & 3) == 0) aff[(size_t)m * NE + (l2 >> 2)] = ex / den;
        }
    }
    if constexpr (ROUTER) __syncthreads();
}

__device__ __forceinline__ void norm_router_mfma(LAS unsigned char* lds, const bf16_t* xin  , int nrows, const float* g, const float* modl  , int sh_chunk, unsigned char* A8, const float* router  , float* aff) {
    const int tid = otid(), lane = tid & 63, wave = __builtin_amdgcn_readfirstlane(tid >> 6), t = lane & 15, q = lane >> 4;
    const int vc = vcu_of_block(), gw = vc * 8 + wave, NGW = gridDim.x * 8;
    LAS float* wT = (LAS float*)lds;
    LAS float* gT = wT + 16 * WTP;
    LAS float* hT = gT + 2048;
    const int per = (nrows + NGW - 1) / NGW;
    const int blk_first = vc * 8 * per, blk_last = (blk_first + 8 * per - 1 < nrows - 1) ? blk_first + 8 * per - 1 : nrows - 1;
    const int mod_lo = blk_first < NX ? blk_first / T : 8;
    {
        float wt[32];
#pragma unroll
        for (int i = 0; i < 32; ++i) wt[i] = router[tid + NTHR * i];
#pragma unroll
        for (int i = 0; i < 32; ++i) { const int k = tid + NTHR * i; wT[(k & 15) * WTP + (k >> 4)] = wt[i]; }
        if (blk_first < nrows) {
            const int mi = tid >> 8, c4 = (tid & 255) * 4; int mr = mod_lo + mi; if (mr > 8) mr = 8;
            const float* shp = modl + (size_t)mr * NADA + sh_chunk * D;
            const f32x4 gg = *(const f32x4*)(g + c4), sc = *(const f32x4*)(shp + D + c4), hh = *(const f32x4*)(shp + c4);
            *(LAS f32x4*)(gT + mi * 1024 + c4) = gg * (sc + 1.f); *(LAS f32x4*)(hT + mi * 1024 + c4) = hh;
        }
        __syncthreads();
    }
    const int mbeg = gw * per, mend = (mbeg + per < nrows) ? mbeg + per : nrows;
    for (int m0 = mbeg; m0 < mend; m0 += 16) {
        const int nr = (mend - m0) < 16 ? (mend - m0) : 16;
        const bool ok = t < nr; const int m = ok ? m0 + t : m0;
        const int modrow = m < NX ? m / T : 8, mi = (modrow != mod_lo) ? 1 : 0;
        const bf16_t* xr = xin + (size_t)m * D + 8 * q;
        float ss = 0.f;
#pragma unroll 8
        for (int s = 0; s < 32; ++s) { const u32x4 w = *(const u32x4*)(xr + 32 * s);
            const f32x2 p0 = unr(w.x), p1 = unr(w.y), p2 = unr(w.z), p3 = unr(w.w);
            ss += (p0.x * p0.x + p0.y * p0.y) + (p1.x * p1.x + p1.y * p1.y) + (p2.x * p2.x + p2.y * p2.y) + (p3.x * p3.x + p3.y * p3.y); }
        ss += __shfl_xor(ss, 16); ss += __shfl_xor(ss, 32);
        const float r = rsqrtf(ss * (1.f / D) + EPS);
        unsigned char* ap = A8 + (size_t)m * D + 8 * q;
        const LAS float* wp = wT + t * WTP + 8 * q;
        const LAS float* gp = gT + mi * 1024 + 8 * q; const LAS float* hp = hT + mi * 1024 + 8 * q;
        f32x4 accA = (f32x4){0.f, 0.f, 0.f, 0.f}, accB = (f32x4){0.f, 0.f, 0.f, 0.f};
        u32x4 xb[4];
#pragma unroll
        for (int i = 0; i < 4; ++i) xb[i] = *(const u32x4*)(xr + 32 * i);
#pragma unroll 1
        for (int s4 = 0; s4 < 8; ++s4) {
#pragma unroll
            for (int i = 0; i < 4; ++i) {
                const int s = 4 * s4 + i; const u32x4 xw = xb[i];
                if (s4 < 7) xb[i] = *(const u32x4*)(xr + 32 * (s + 4));
                const f32x2 q0 = unr(xw.x), q1 = unr(xw.y), q2 = unr(xw.z), q3 = unr(xw.w);
                const f32x4 g0 = *(const LAS f32x4*)(gp + 32 * s), g1 = *(const LAS f32x4*)(gp + 32 * s + 4), h0 = *(const LAS f32x4*)(hp + 32 * s), h1 = *(const LAS f32x4*)(hp + 32 * s + 4);
                const f32x4 w0 = *(const LAS f32x4*)(wp + 32 * s), w1 = *(const LAS f32x4*)(wp + 32 * s + 4);
                const f32x4 v0 = (f32x4){q0.x, q0.y, q1.x, q1.y} * r * g0 + h0, v1 = (f32x4){q2.x, q2.y, q3.x, q3.y} * r * g1 + h1;
                if (ok) { u32x2 w; w.x = pk4_fp8(v0.x * ACT_SCALE, v0.y * ACT_SCALE, v0.z * ACT_SCALE, v0.w * ACT_SCALE); w.y = pk4_fp8(v1.x * ACT_SCALE, v1.y * ACT_SCALE, v1.z * ACT_SCALE, v1.w * ACT_SCALE);
                    *(u32x2*)(ap + 32 * s) = w; }
                accA = __builtin_amdgcn_mfma_f32_16x16x4f32(w0.x, v0.x, accA, 0, 0, 0); accB = __builtin_amdgcn_mfma_f32_16x16x4f32(w1.x, v1.x, accB, 0, 0, 0);
                accA = __builtin_amdgcn_mfma_f32_16x16x4f32(w0.y, v0.y, accA, 0, 0, 0); accB = __builtin_amdgcn_mfma_f32_16x16x4f32(w1.y, v1.y, accB, 0, 0, 0);
                accA = __builtin_amdgcn_mfma_f32_16x16x4f32(w0.z, v0.z, accA, 0, 0, 0); accB = __builtin_amdgcn_mfma_f32_16x16x4f32(w1.z, v1.z, accB, 0, 0, 0);
                accA = __builtin_amdgcn_mfma_f32_16x16x4f32(w0.w, v0.w, accA, 0, 0, 0); accB = __builtin_amdgcn_mfma_f32_16x16x4f32(w1.w, v1.w, accB, 0, 0, 0);
            }
        }
        const f32x4 acc = accA + accB;
        float mx = fmaxf(fmaxf(acc.x, acc.y), fmaxf(acc.z, acc.w));
        mx = fmaxf(mx, __shfl_xor(mx, 16)); mx = fmaxf(mx, __shfl_xor(mx, 32));
        const f32x4 ex = (f32x4){__expf(acc.x - mx), __expf(acc.y - mx), __expf(acc.z - mx), __expf(acc.w - mx)};
        float den = (ex.x + ex.y) + (ex.z + ex.w);
        den += __shfl_xor(den, 16); den += __shfl_xor(den, 32);
        if (ok) *(f32x4*)(aff + (size_t)m * NE + 4 * q) = (f32x4){ex.x / den, ex.y / den, ex.z / den, ex.w / den};
    }
    __syncthreads();
}

__device__ __forceinline__ void topk_item(LAS unsigned long long* keys, const float* aff_re  , int N, int cap, int* pos_re  , int* rowtab_slot, int rowbase) {
    const int tid = otid(), lane = tid & 63, wave = tid >> 6;
    { float av[4];
#pragma unroll
      for (int q = 0; q < 4; ++q) { const int i = tid + NTHR * q; av[q] = i < N ? aff_re[(size_t)i * NE] : 0.f; }
#pragma unroll
      for (int q = 0; q < 4; ++q) { const int i = tid + NTHR * q; if (i < N) keys[i] = ((unsigned long long)(~__builtin_bit_cast(unsigned, av[q])) << 32) | (unsigned)i; } }
    __syncthreads();
    const bool active = wave * 256 < N;
    for (int k = 2; k <= N; k <<= 1)
        for (int j = k >> 1; j > 0; j >>= 1) {
            if (j >= 256) {
                for (int c = tid; c < N / 2; c += NTHR) {
                    const int i = 2 * c - (c & (j - 1)), l = i + j;
                    const bool up = (i & k) == 0;
                    const unsigned long long a = keys[i], b = keys[l];
                    if ((a > b) == up) { keys[i] = b; keys[l] = a; }
                }
                __syncthreads();
            } else if (active) {
#pragma unroll
                for (int cc = 0; cc < 2; ++cc) {
                    const int c = wave * 128 + cc * 64 + lane;
                    const int i = 2 * c - (c & (j - 1)), l = i + j;
                    const bool up = (i & k) == 0;
                    const unsigned long long a = keys[i], b = keys[l];
                    if ((a > b) == up) { keys[i] = b; keys[l] = a; }
                }
                asm volatile("s_waitcnt lgkmcnt(0)" ::: "memory");
            }
            if (j == 1) __syncthreads();
        }
    for (int p = tid; p < N; p += NTHR) { const int tok = (int)(unsigned)keys[p]; pos_re[(size_t)tok * NE] = p; if (p < cap) rowtab_slot[p] = rowbase + tok; }
    __syncthreads();
}
__device__ __forceinline__ void phase_topk(const Params& P, LAS unsigned char* lds, bool with_ctx) {
    unsigned char* ws = P.ws;
    LAS unsigned long long* keys = (LAS unsigned long long*)lds;
    const int nitems = with_ctx ? 256 : 128;
    int* rowtab = (int*)(ws + WS_ROWTAB); const float* aff = (const float*)(ws + WS_AFF); int* pos = (int*)(ws + WS_POS);
    for (int it = blockIdx.x; it < nitems; it += gridDim.x) {
        const int be = it >> (with_ctx ? 1 : 0); const bool isc = with_ctx && (it & 1);
        const int b = be >> 4, e = be & 15;
        if (!isc) topk_item(keys, aff + (size_t)(b * T) * NE + e, T, CAPX, pos + (size_t)(b * T) * NE + e, rowtab + (e * 8 + b) * 256, b * T);
        else topk_item(keys, aff + (size_t)(NX + b * TC) * NE + e, TC, CAPC, pos + (size_t)(NX + b * TC) * NE + e, rowtab + (128 + e) * 256 + b * 32, NX + b * TC);
    }
    const int wave = __builtin_amdgcn_readfirstlane(otid() >> 6);
    if (gridDim.x == 256) {
        if (with_ctx) { if (blockIdx.x & 1) f8_convert_range(P, lds, F8_S1, F8_N1, (blockIdx.x >> 1) * 8 + wave, 128 * 8, 1 << 30, 0); }
        else if (blockIdx.x >= 128) f8_convert_range(P, lds, F8_S4, F8_N4, (blockIdx.x - 128) * 8 + wave, 128 * 8, 1 << 30, 0);
    }
}

__device__ __forceinline__ void combine_rows(const Params& P, const bf16_t* xin, bf16_t* xout, int nrows, const float* modl,
                                             const float* gnext, const float* modnext  , bf16_t* A, float* fout, const float* gfinal) {
    unsigned char* ws = P.ws;
    const int tid = otid(), lane = tid & 63, wave = __builtin_amdgcn_readfirstlane(tid >> 6);
    const int gw = vcu_of_block() * 8 + wave, NGW = gridDim.x * 8;
    const unsigned char* ys = (const unsigned char*)(ws + WS_YS);
    const int* pos = (const int*)(ws + WS_POS); const float* aff = (const float*)(ws + WS_AFF);
    const int l16 = lane & 15;
    const int per = (nrows + NGW - 1) / NGW, mbeg = gw * per, mend = (mbeg + per < nrows) ? mbeg + per : nrows;
    u32x2 xn[4]; f32x4 gt[4], gs[4], sh4[4]; int pn = 0; float an = 0.f; int curmod = -1;
    if (mbeg < mend) { const u32x2* xr = (const u32x2*)(xin + (size_t)mbeg * D) + lane;
#pragma unroll
        for (int j = 0; j < 4; ++j) xn[j] = __builtin_nontemporal_load(xr + 64 * j);
        pn = pos[(size_t)mbeg * NE + l16]; an = aff[(size_t)mbeg * NE + l16]; }
    for (int m = mbeg; m < mend; ++m) {
        f32x4 v[4];
#pragma unroll
        for (int j = 0; j < 4; ++j) { const f32x2 c0 = unr(xn[j].x), c1 = unr(xn[j].y); v[j] = (f32x4){c0.x, c0.y, c1.x, c1.y}; }
        const int pc = pn; const float ac = an;
        if (m + 1 < mend) { const u32x2* xr = (const u32x2*)(xin + (size_t)(m + 1) * D) + lane;
#pragma unroll
            for (int j = 0; j < 4; ++j) xn[j] = __builtin_nontemporal_load(xr + 64 * j);
            pn = pos[(size_t)(m + 1) * NE + l16]; an = aff[(size_t)(m + 1) * NE + l16]; }
        const bool isx = m < NX; const int b = isx ? m / T : (m - NX) / TC, modrow = isx ? b : 8, cap = isx ? CAPX : CAPC;
        if (modrow != curmod) { curmod = modrow; const float* gp = modl + (size_t)modrow * NADA + 5 * D;
#pragma unroll
            for (int j = 0; j < 4; ++j) { const int e = 4 * lane + 256 * j; gt[j] = *(const f32x4*)(gp + e);
                if (modnext) { const float* shp = modnext + (size_t)modrow * NADA; gs[j] = *(const f32x4*)(gnext + e) * (*(const f32x4*)(shp + D + e) + 1.f); sh4[j] = *(const f32x4*)(shp + e); }
                else { gs[j] = *(const f32x4*)(gfinal + e); sh4[j] = (f32x4){0.f, 0.f, 0.f, 0.f}; } } }
        unsigned long long mask = __ballot(pc < cap) & 0xffffull;
        f32x4 a[4];
#pragma unroll
        for (int j = 0; j < 4; ++j) a[j] = (f32x4){0.f, 0.f, 0.f, 0.f};
        while (mask) {
            const int e = __builtin_ctzll(mask); mask &= mask - 1;
            const int pe = __builtin_amdgcn_readlane(pc, e); const float af = __builtin_bit_cast(float, __builtin_amdgcn_readlane(__builtin_bit_cast(int, ac), e)) * (1.f / YS_SCALE);
            const size_t yrow = isx ? (size_t)(e * 8 + b) * 256 + pe : (size_t)(128 + e) * 256 + b * 32 + pe;
            const unsigned char* yr = ys + yrow * D + 4 * lane;
#pragma unroll
            for (int j = 0; j < 4; ++j) { const unsigned w = __builtin_nontemporal_load((const unsigned*)(yr + 256 * j));
                const f32x2 lo = __builtin_amdgcn_cvt_pk_f32_fp8(w, false), hi = __builtin_amdgcn_cvt_pk_f32_fp8(w, true);
                a[j].x += af * lo.x; a[j].y += af * lo.y; a[j].z += af * hi.x; a[j].w += af * hi.y; }
        }
        float s = 0.f;
#pragma unroll
        for (int j = 0; j < 4; ++j) { v[j] = v[j] + gt[j] * a[j]; s += (v[j].x * v[j].x + v[j].y * v[j].y) + (v[j].z * v[j].z + v[j].w * v[j].w); }
        const float r = rsqrtf(wave_sum(s) * (1.f / D) + EPS);
        if (modnext) {
#pragma unroll
            for (int j = 0; j < 4; ++j) { const int e = 4 * lane + 256 * j;
                { u32x2 xw; xw.x = pkr(v[j].x, v[j].y); xw.y = pkr(v[j].z, v[j].w); *(u32x2*)(xout + (size_t)m * D + e) = xw; }
                const f32x4 hv = v[j] * r * gs[j] + sh4[j];
                u32x2 w; w.x = pk2(hv.x, hv.y); w.y = pk2(hv.z, hv.w); *(u32x2*)(A + (size_t)m * D + e) = w; }
        } else {
#pragma unroll
            for (int j = 0; j < 4; ++j) { const int e = 4 * lane + 256 * j; __builtin_nontemporal_store(v[j] * r * gs[j], (f32x4*)(fout + (size_t)m * D + e)); }
        }
    }
}

constexpr int TP = 264;
typedef short s16x4 __attribute__((ext_vector_type(4)));
__device__ __forceinline__ void mlstm_m1(const Params& P, LAS unsigned char* lds) {
    const int tid = otid(), lane = tid & 63, wave = __builtin_amdgcn_readfirstlane(tid >> 6), G = gridDim.x, fr = lane & 15, fq = lane >> 4;
    unsigned char* ws = P.ws;
    const bf16_t* pb = (const bf16_t*)(ws + WS_BIG); const float* gates = (const float*)(ws + WS_GATES);
    constexpr int VP = 144, KP = 72;
    LAS bf16_t* Vs = (LAS bf16_t*)lds;
    LAS bf16_t* Ks = Vs + 256 * VP;
    LAS float* fa = (LAS float*)(Ks + 256 * KP);
    LAS float* sF = fa; LAS float* sB = fa + 512; LAS float* esF = fa + 1024; LAS float* esB = fa + 1280; LAS float* mxs = fa + 1536; LAS float* red = fa + 2048;
    const int trq = (lane & 15) >> 2, trp = lane & 3;
    for (int it = blockIdx.x; it < NB * NH * 9; it += G) {
        const int ch = it % 9, bh = it / 9, h = bh & 7, b = bh >> 3;
        const int row0 = ch == 0 ? NX + b * TC : b * T + (ch - 1) * 256;
        float* gb = (float*)(ws + WS_GBUF) + (size_t)it * GB_STRIDE;
        u32x4 kreg[4], vreg[8];
#pragma unroll
        for (int i = 0; i < 4; ++i) { const int piece = tid + NTHR * i, sr = piece >> 3, seg = piece & 7; kreg[i] = *(const u32x4*)(pb + (size_t)(row0 + sr) * NQKVO + 512 + h * 64 + seg * 8); }
#pragma unroll
        for (int i = 0; i < 8; ++i) { const int piece = tid + NTHR * i, sr = piece >> 4, seg = piece & 15; vreg[i] = *(const u32x4*)(pb + (size_t)(row0 + sr) * NQKVO + 1024 + h * 128 + seg * 8); }
        if (wave < 2) {
            const int dirw = wave;
            const float* gr = gates + (size_t)(row0 + 4 * lane) * 32 + h + 16 * dirw;
            float gi[4], lf[4], a[4];
#pragma unroll
            for (int j = 0; j < 4; ++j) { gi[j] = gr[j * 32]; lf[j] = gr[j * 32 + 8]; }
#pragma unroll
            for (int j = 0; j < 4; ++j) lf[j] = logsigmoidf(lf[j]);
            if (dirw == 0) { a[0] = lf[0]; a[1] = a[0] + lf[1]; a[2] = a[1] + lf[2]; a[3] = a[2] + lf[3]; }
            else { a[3] = lf[3]; a[2] = a[3] + lf[2]; a[1] = a[2] + lf[1]; a[0] = a[1] + lf[0]; }
            const float tot = dirw == 0 ? a[3] : a[0];
            float inc = tot;
#pragma unroll
            for (int o = 1; o < 64; o <<= 1) { const float t = dirw == 0 ? __shfl_up(inc, o) : __shfl_down(inc, o); if (dirw == 0 ? (lane >= o) : (lane + o < 64)) inc += t; }
            const float off = inc - tot;
            f32x4 bb, uu; float mx;
#pragma unroll
            for (int j = 0; j < 4; ++j) { bb[j] = off + a[j]; uu[j] = gi[j] - bb[j]; }
            mx = fmaxf(fmaxf(uu[0], uu[1]), fmaxf(uu[2], uu[3]));
#pragma unroll
            for (int o = 1; o < 64; o <<= 1) mx = fmaxf(mx, __shfl_xor(mx, o));
            LAS float* esd = dirw ? esB : esF;
            *(LAS f32x4*)(esd + 4 * lane) = (f32x4){__expf(uu[0] - mx), __expf(uu[1] - mx), __expf(uu[2] - mx), __expf(uu[3] - mx)};
            *(f32x4*)(gb + 512 * dirw + 4 * lane) = bb; *(f32x4*)(gb + 512 * dirw + 256 + 4 * lane) = uu;
            const float total = __shfl(inc, dirw ? 0 : 63);
            if (lane == 0) { gb[1024 + dirw] = mx; gb[1026 + dirw] = total; }
        }
#pragma unroll
        for (int i = 0; i < 8; ++i) { const int piece = tid + NTHR * i, sr = piece >> 4, seg = piece & 15; *(LAS u32x4*)(Vs + sr * VP + seg * 8) = vreg[i]; }
        __syncthreads();
        const size_t seq0 = (size_t)bh * 2;
#pragma unroll 1
        for (int dir = 0; dir < 2; ++dir) {
            const LAS float* esd = dir ? esB : esF;
#pragma unroll
            for (int i = 0; i < 4; ++i) { const int piece = tid + NTHR * i, sr = piece >> 3, seg = piece & 7; const float ef = esd[sr];
                const unsigned wv[4] = {kreg[i].x, kreg[i].y, kreg[i].z, kreg[i].w}; u32x4 o; unsigned ov[4];
#pragma unroll
                for (int q = 0; q < 4; ++q) ov[q] = pk2(__builtin_bit_cast(float, wv[q] << 16) * ef, __builtin_bit_cast(float, wv[q] & 0xffff0000u) * ef);
                o.x = ov[0]; o.y = ov[1]; o.z = ov[2]; o.w = ov[3];
                *(LAS u32x4*)(Ks + sr * KP + seg * 8) = o; }
            __syncthreads();
            { const int d = tid & 63, part = tid >> 6; float sacc = 0.f;
#pragma unroll 8
                for (int ss = 0; ss < 32; ++ss) sacc += bf2f(Ks[(part * 32 + ss) * KP + d]);
                red[part * 64 + d] = sacc; }
            f32x4 acc[4];
#pragma unroll
            for (int dt = 0; dt < 4; ++dt) acc[dt] = (f32x4){0.f, 0.f, 0.f, 0.f};
#pragma unroll
            for (int ks = 0; ks < 8; ++ks) {
                const LAS bf16_t* vb = Vs + (32 * ks + 4 * fq + trq) * VP + 16 * wave + 4 * trp;
                const s16x4 x0 = __builtin_amdgcn_ds_read_tr16_b64_v4i16((LAS s16x4*)vb), x1 = __builtin_amdgcn_ds_read_tr16_b64_v4i16((LAS s16x4*)(vb + 16 * VP));
                const bf16x8 X = __builtin_shufflevector(x0, x1, 0, 1, 2, 3, 4, 5, 6, 7);
                const LAS bf16_t* kb_ = Ks + (32 * ks + 4 * fq + trq) * KP + 4 * trp;
#pragma unroll
                for (int dt = 0; dt < 4; ++dt) {
                    const s16x4 y0 = __builtin_amdgcn_ds_read_tr16_b64_v4i16((LAS s16x4*)(kb_ + 16 * dt)), y1 = __builtin_amdgcn_ds_read_tr16_b64_v4i16((LAS s16x4*)(kb_ + 16 * KP + 16 * dt));
                    const bf16x8 Y = __builtin_shufflevector(y0, y1, 0, 1, 2, 3, 4, 5, 6, 7);
                    acc[dt] = __builtin_amdgcn_mfma_f32_16x16x32_bf16(X, Y, acc[dt], 0, 0, 0); }
            }
            float* kl = (float*)(ws + WS_KLOC) + ((seq0 + dir) * 9 + ch) * 8192;
#pragma unroll
            for (int dt = 0; dt < 4; ++dt)
#pragma unroll
                for (int r = 0; r < 4; ++r) kl[(16 * wave + 4 * fq + r) * 64 + 16 * dt + fr] = acc[dt][r];
            __syncthreads();
            if (tid < 64) { float sacc = 0.f;
#pragma unroll
                for (int q = 0; q < 8; ++q) sacc += red[q * 64 + tid];
                ((float*)(ws + WS_NLOC))[((seq0 + dir) * 9 + ch) * 64 + tid] = sacc; }
            __syncthreads();
        }
    }
}
__device__ __forceinline__ void mlstm_m2(const Params& P) {
    const int tid = otid(), G = gridDim.x;
    unsigned char* ws = P.ws;
    for (int it = blockIdx.x; it < 256; it += G) {
        const int seq = it >> 1, half = it & 1, dir = seq & 1, bh = seq >> 1;
        const int e0 = half * 4096 + tid * 8;
        const float* kl = (const float*)(ws + WS_KLOC) + (size_t)seq * 9 * 8192 + e0;
        const float* nl = (const float*)(ws + WS_NLOC) + (size_t)seq * 9 * 64;
        const float* gbs = (const float*)(ws + WS_GBUF) + (size_t)bh * 9 * GB_STRIDE + 1024;
        bf16_t* cs = (bf16_t*)(ws + WS_CSTAR) + (size_t)seq * 8 * 8192 + e0;
        float* ns = (float*)(ws + WS_NSTAR) + (size_t)seq * 8 * 64; float* rb = (float*)(ws + WS_RBUF) + (size_t)seq * 8;
        const bool nthr = (half == 0 && tid < 64);
        float C[8], n = 0.f, m = 0.f;
#pragma unroll
        for (int i = 0; i < 8; ++i) C[i] = 0.f;
        f32x4 k0a[9], k1a[9]; float cca[9], bla[9], nla[9];
#pragma unroll
        for (int st = 0; st < 9; ++st) { const int ch = dir == 0 ? st : (st == 0 ? 0 : 9 - st);
            k0a[st] = __builtin_nontemporal_load((const f32x4*)(kl + (size_t)ch * 8192)); k1a[st] = __builtin_nontemporal_load((const f32x4*)(kl + (size_t)ch * 8192 + 4));
            cca[st] = gbs[(size_t)ch * GB_STRIDE + dir]; bla[st] = gbs[(size_t)ch * GB_STRIDE + 2 + dir];
            nla[st] = nthr ? nl[ch * 64 + tid] : 0.f; }
#pragma unroll
        for (int st = 0; st < 9; ++st) {
            const int ch = dir == 0 ? st : (st == 0 ? 0 : 9 - st);
            const float cc = cca[st], bl = bla[st];
            if (ch >= 1) {
                const int tc = ch - 1; const float R = fmaxf(cc, m), sc = __expf(m - R);
                u32x4 w; w.x = pk2(C[0] * sc, C[1] * sc); w.y = pk2(C[2] * sc, C[3] * sc); w.z = pk2(C[4] * sc, C[5] * sc); w.w = pk2(C[6] * sc, C[7] * sc);
                *(u32x4*)(cs + (size_t)tc * 8192) = w;
                if (nthr) ns[tc * 64 + tid] = n * sc;
                if (half == 0 && tid == 0) rb[tc] = R;
            }
            if (st < 8) {
                const float mloc = bl + cc, mnew = fmaxf(bl + m, mloc), a = __expf(bl + m - mnew), bb = __expf(mloc - mnew);
                const f32x4 k0 = k0a[st], k1 = k1a[st];
                C[0] = a * C[0] + bb * k0.x; C[1] = a * C[1] + bb * k0.y; C[2] = a * C[2] + bb * k0.z; C[3] = a * C[3] + bb * k0.w;
                C[4] = a * C[4] + bb * k1.x; C[5] = a * C[5] + bb * k1.y; C[6] = a * C[6] + bb * k1.z; C[7] = a * C[7] + bb * k1.w;
                if (nthr) n = a * n + bb * nla[st];
                m = mnew;
            }
        }
    }
}
__device__ __forceinline__ void mlstm_m3(const Params& P, LAS unsigned char* lds) {
    const int tid = otid(), lane = tid & 63, wave = __builtin_amdgcn_readfirstlane(tid >> 6), G = gridDim.x, fr = lane & 15, fq = lane >> 4;
    unsigned char* ws = P.ws;
    const bf16_t* pb = (const bf16_t*)(ws + WS_BIG);
    constexpr int VP = 144;
    LAS bf16_t* Vs = (LAS bf16_t*)lds;
    LAS bf16_t* Ks = Vs + 256 * VP;
    LAS bf16_t* Cs = Ks + 256 * 64;
    LAS float* fa = (LAS float*)(Cs + 2 * 128 * 64);
    LAS float* es = fa;
    LAS float* low = fa + 512;
    LAS float* n0 = fa + 1024;
    bf16_t* A = (bf16_t*)(ws + WS_ABF);
    const int trq = (lane & 15) >> 2, trp = lane & 3;
    for (int it = blockIdx.x; it < NB * NH * 8; it += G) {
        const int tc = it & 7, bh = it >> 3, h = bh & 7, b = bh >> 3;
        const int row0 = b * T + tc * 256;
        const float* gb = (const float*)(ws + WS_GBUF) + (size_t)(bh * 9 + tc + 1) * GB_STRIDE;
        const size_t seq0 = (size_t)bh * 2;
        const float* rbuf = (const float*)(ws + WS_RBUF);
        {
            const int dir = tid >> 8, sidx = tid & 255;
            const float R = rbuf[(seq0 + dir) * 8 + tc];
            const float bb = gb[dir * 512 + sidx], uu = gb[dir * 512 + 256 + sidx];
            es[dir * 256 + sidx] = __expf(uu - R); low[dir * 256 + sidx] = __expf(fminf(-bb - R, 80.f));
            if (tid < 128) n0[tid] = ((const float*)(ws + WS_NSTAR))[((seq0 + (tid >> 6)) * 8 + tc) * 64 + (tid & 63)];
        }
#pragma unroll
        for (int i = 0; i < 4; ++i) { const int piece = tid + NTHR * i, sr = piece >> 3, seg = piece & 7;
            *(LAS u32x4*)(Ks + sr * 64 + ((seg ^ (sr & 7)) << 3)) = __builtin_nontemporal_load((const u32x4*)(pb + (size_t)(row0 + sr) * NQKVO + 512 + h * 64 + seg * 8)); }
#pragma unroll
        for (int i = 0; i < 4; ++i) { const int piece = tid + NTHR * i, cr = piece >> 3, seg = piece & 7;
            *(LAS u32x4*)(Cs + cr * 64 + ((seg ^ (cr & 7)) << 3)) = __builtin_nontemporal_load((const u32x4*)((const bf16_t*)(ws + WS_CSTAR) + ((seq0 + (cr >> 7)) * 8 + tc) * 8192 + (cr & 127) * 64 + seg * 8)); }
#pragma unroll
        for (int i = 0; i < 8; ++i) { const int piece = tid + NTHR * i, sr = piece >> 4, seg = piece & 15;
            *(LAS u32x4*)(Vs + sr * VP + seg * 8) = __builtin_nontemporal_load((const u32x4*)(pb + (size_t)(row0 + sr) * NQKVO + 1024 + h * 128 + seg * 8)); }
        bf16x8 Qa[2][2];
#pragma unroll
        for (int rti = 0; rti < 2; ++rti)
#pragma unroll
            for (int kk = 0; kk < 2; ++kk) Qa[rti][kk] = *(const bf16x8*)(pb + (size_t)(row0 + 16 * (wave + 8 * rti) + fr) * NQKVO + h * 64 + 32 * kk + 8 * fq);
        __syncthreads();
#pragma unroll
        for (int rti = 0; rti < 2; ++rti) {
            const int rt = wave + 8 * rti, rw = rt >> 1, jl0 = 16 * (rt & 1);
            const bf16x8 Qf[2] = {Qa[rti][0], Qa[rti][1]};
            const size_t row = (size_t)(row0 + 16 * rt + fr);
            u32x2 ow[8];
#pragma unroll
            for (int dvt = 0; dvt < 8; ++dvt) ow[dvt] = *(const u32x2*)(pb + row * NQKVO + 2048 + h * 128 + 16 * dvt + 4 * fq);
            f32x4 hs[8];
#pragma unroll
            for (int dvt = 0; dvt < 8; ++dvt) hs[dvt] = (f32x4){0.f, 0.f, 0.f, 0.f};
#pragma unroll 1
            for (int dir = 0; dir < 2; ++dir) {
                f32x4 acc[8]; float den = 0.f;
#pragma unroll
                for (int dvt = 0; dvt < 8; ++dvt) acc[dvt] = (f32x4){0.f, 0.f, 0.f, 0.f};
#pragma unroll
                for (int dvt = 0; dvt < 8; ++dvt)
#pragma unroll
                    for (int kk = 0; kk < 2; ++kk) { const int cr = dir * 128 + 16 * dvt + fr;
                        const bf16x8 Cf = *(const LAS bf16x8*)(Cs + cr * 64 + (((4 * kk + fq) ^ (cr & 7)) << 3));
                        acc[dvt] = __builtin_amdgcn_mfma_f32_16x16x32_bf16(Cf, Qf[kk], acc[dvt], 0, 0, 0); }
#pragma unroll
                for (int kk = 0; kk < 2; ++kk)
#pragma unroll
                    for (int e = 0; e < 8; ++e) den += n0[dir * 64 + 32 * kk + 8 * fq + e] * bf2f((unsigned short)Qf[kk][e]);
                const int sb_lo = dir == 0 ? 0 : rw, sb_hi = dir == 0 ? rw : 7;
#pragma unroll 2
                for (int sb = sb_lo; sb <= sb_hi; ++sb) {
                    const int s0 = 32 * sb; const bool diag = (sb == rw);
                    f32x4 ST[2];
#pragma unroll
                    for (int st = 0; st < 2; ++st) { ST[st] = (f32x4){0.f, 0.f, 0.f, 0.f};
#pragma unroll
                        for (int kk = 0; kk < 2; ++kk) { const int sr = s0 + 16 * st + fr;
                            const bf16x8 Kf = *(const LAS bf16x8*)(Ks + sr * 64 + (((4 * kk + fq) ^ (sr & 7)) << 3));
                            ST[st] = __builtin_amdgcn_mfma_f32_16x16x32_bf16(Kf, Qf[kk], ST[st], 0, 0, 0); } }
                    float pv[8];
#pragma unroll
                    for (int st = 0; st < 2; ++st) { const f32x4 ev = *(const LAS f32x4*)(es + dir * 256 + s0 + 16 * st + 4 * fq);
#pragma unroll
                        for (int r = 0; r < 4; ++r) { const int sl = 16 * st + 4 * fq + r, jl = jl0 + fr;
                            float v = ST[st][r] * ev[r];
                            if (diag) { const bool keep = dir == 0 ? (sl <= jl) : (sl >= jl); v = keep ? v : 0.f; }
                            pv[4 * st + r] = v; den += v; } }
                    u32x4 pw; pw.x = pk2(pv[0], pv[1]); pw.y = pk2(pv[2], pv[3]); pw.z = pk2(pv[4], pv[5]); pw.w = pk2(pv[6], pv[7]);
                    const bf16x8 Pb = __builtin_bit_cast(bf16x8, pw);
                    const LAS bf16_t* vb = Vs + (s0 + 4 * fq + trq) * VP + 4 * trp;
#pragma unroll
                    for (int dvt = 0; dvt < 8; ++dvt) {
                        const s16x4 v0 = __builtin_amdgcn_ds_read_tr16_b64_v4i16((LAS s16x4*)(vb + 16 * dvt));
                        const s16x4 v1 = __builtin_amdgcn_ds_read_tr16_b64_v4i16((LAS s16x4*)(vb + 16 * VP + 16 * dvt));
                        const bf16x8 Vf = __builtin_shufflevector(v0, v1, 0, 1, 2, 3, 4, 5, 6, 7);
                        acc[dvt] = __builtin_amdgcn_mfma_f32_16x16x32_bf16(Vf, Pb, acc[dvt], 0, 0, 0);
                    }
                }
                float dn = den; dn += __shfl_xor(dn, 16); dn += __shfl_xor(dn, 32);
                const float inv = __builtin_amdgcn_rcpf(fmaxf(fabsf(dn), low[dir * 256 + 16 * rt + fr]));
#pragma unroll
                for (int dvt = 0; dvt < 8; ++dvt) hs[dvt] = hs[dvt] + acc[dvt] * inv;
            }
            float ss = 0.f;
#pragma unroll
            for (int dvt = 0; dvt < 8; ++dvt) { const f32x4 v = hs[dvt]; ss += (v.x * v.x + v.y * v.y) + (v.z * v.z + v.w * v.w); }
            ss += __shfl_xor(ss, 16); ss += __shfl_xor(ss, 32);
            const float rn = rsqrtf(ss * (1.f / DV) + EPS);
            f32x4 ngv[8];
#pragma unroll
            for (int dvt = 0; dvt < 8; ++dvt) ngv[dvt] = *(const f32x4*)(P.mlstm_norm + h * 128 + 16 * dvt + 4 * fq);
#pragma unroll
            for (int dvt = 0; dvt < 8; ++dvt) { const int col = h * 128 + 16 * dvt + 4 * fq;
                const f32x4 ng = ngv[dvt];
                const float o0 = sigmoidf(__builtin_bit_cast(float, ow[dvt].x << 16)), o1 = sigmoidf(__builtin_bit_cast(float, ow[dvt].x & 0xffff0000u)),
                            o2 = sigmoidf(__builtin_bit_cast(float, ow[dvt].y << 16)), o3 = sigmoidf(__builtin_bit_cast(float, ow[dvt].y & 0xffff0000u));
                const f32x4 v = hs[dvt] * rn * ng;
                *(unsigned*)((unsigned char*)A + row * D + col) = pk4_fp8(v.x * o0 * ACT_SCALE, v.y * o1 * ACT_SCALE, v.z * o2 * ACT_SCALE, v.w * o3 * ACT_SCALE); }
        }
        __syncthreads();
    }
}

#ifndef GEMM_BODY
#define GEMM_BODY gemm_pipe<false>
#endif
enum { PH_P0 = 0, PH_VP, PH_POOLG, PH_NORM0, PH_TOPK0, PH_G1_0, PH_G2_0, PH_COMB0, PH_INPROJ, PH_M1, PH_M2, PH_M3, PH_OUTG, PH_NORM1, PH_TOPK1, PH_G1_1, PH_G2_1, PH_COMB1, PH_COUNT };

template <int PH>
__device__ __forceinline__ void run_phase(const Params& P, LAS unsigned char* lds) {
    unsigned char* ws = P.ws;
    const float* mod0 = (const float*)(ws + WS_MOD); const float* mod1 = mod0 + 9 * NADA;
    float* XA = (float*)(ws + WS_XA); float* XB = (float*)(ws + WS_XB); bf16_t* ABF = (bf16_t*)(ws + WS_ABF);
    const int G = gridDim.x, vc = vcu_of_block();
    if constexpr (PH == PH_P0) { phase1(P, lds); phase0(P, lds); }
    else if constexpr (PH == PH_VP) { ctx_pool(P); phase2(P, lds); }
    else if constexpr (PH == PH_POOLG) {
        GemmDesc g{ABF, D, nullptr, (const bf16_t*)(ws + WS_POOLWT), 256, 256};
        SchedGrid S{NX / 256, 4, G, vc, 256, 1};
        EpiResid<true> E{(const bf16_t*)XB, (const bf16_t*)XB, (bf16_t*)XA, mod0 + 2 * D, P.pool_scale};
        GEMM_BODY(lds, g, S, E);
        pool_ctx_subtiles(P, (bf16_t*)XA);
    } else if constexpr (PH == PH_NORM0) norm_router_mfma(lds, (const bf16_t*)XA, NR, P.norm_ffn, mod0, 3, (unsigned char*)ABF, P.router, (float*)(ws + WS_AFF));
    else if constexpr (PH == PH_TOPK0) phase_topk(P, lds, true);
    else if constexpr (PH == PH_G1_0 || PH == PH_G1_1) {
        constexpr int L = PH == PH_G1_1;
        GemmDesc g{ABF, D, (const int*)(ws + WS_ROWTAB), (const bf16_t*)(ws + WS_WGUT), D, D};
        SchedMoe S{L ? 128 : 144, 16, G, vc, L * NE * 16};
        EpiSwigluF8 E{(unsigned char*)(ws + WS_BIG)};
        gemm_pipe<true>(lds, g, S, E);
    } else if constexpr (PH == PH_G2_0 || PH == PH_G2_1) {
        constexpr int L = PH == PH_G2_1;
        GemmDesc g{(const bf16_t*)(ws + WS_BIG), FH, nullptr, (const bf16_t*)(ws + WS_WDT), FH, FH};
        SchedMoe S{L ? 128 : 144, 4, G, vc, L * NE * 4};
        EpiYsF8 E{(unsigned char*)(ws + WS_YS)};
        gemm_pipe<true>(lds, g, S, E);
        if constexpr (!L) { if (G == 256 && vc >= 64) f8_convert_range(P, lds, F8_S2, F8_N2, (vc - 64) * 8 + __builtin_amdgcn_readfirstlane(otid() >> 6), 192 * 8, 1 << 30, 0); }
    } else if constexpr (PH == PH_COMB0) combine_rows(P, (const bf16_t*)XA, (bf16_t*)XB, NR, mod0, P.norm_mix + D, mod1, ABF, nullptr, nullptr);
    else if constexpr (PH == PH_INPROJ) {
        GemmDesc g{ABF, D, nullptr, (const bf16_t*)(ws + WS_WINT), D, D};
        SchedInproj S{G, vc};
        EpiInproj E{(bf16_t*)(ws + WS_BIG), (float*)(ws + WS_GATES), P.b_gates};
        GEMM_BODY(lds, g, S, E);
        if (G == 256 && vc >= 120) f8_convert_range(P, lds, F8_S3, F8_N3, (vc - 120) * 8 + __builtin_amdgcn_readfirstlane(otid() >> 6), 136 * 8, 1 << 30, 0);
    } else if constexpr (PH == PH_M1) { mlstm_m1(P, lds);
        if (G == 256 && blockIdx.x >= 64) f8_convert_range(P, lds, F8_S5, F8_N5, (blockIdx.x - 64) * 8 + __builtin_amdgcn_readfirstlane(otid() >> 6), 192 * 8, 1 << 30, 0); }
    else if constexpr (PH == PH_M2) mlstm_m2(P);
    else if constexpr (PH == PH_M3) mlstm_m3(P, lds);
    else if constexpr (PH == PH_OUTG) {
        GemmDesc g{ABF, D, nullptr, (const bf16_t*)(ws + WS_WOUTT), D, D};
        SchedGrid S{NX / 256, 4, G, vc, 0, 1};
        EpiResid<true> E{(const bf16_t*)XB, (const bf16_t*)XB + (size_t)NX * D, (bf16_t*)XA, mod1 + 2 * D, nullptr};
        gemm_pipe<true>(lds, g, S, E);
    } else if constexpr (PH == PH_NORM1) norm_router_mfma(lds, (const bf16_t*)XA, NX, P.norm_ffn + D, mod1, 3, (unsigned char*)ABF, P.router + D * NE, (float*)(ws + WS_AFF));
    else if constexpr (PH == PH_TOPK1) phase_topk(P, lds, false);
    else if constexpr (PH == PH_COMB1) combine_rows(P, (const bf16_t*)XA, nullptr, NX, mod1, nullptr, nullptr, nullptr, P.out, P.final_norm);
}


#define GAS __attribute__((address_space(1)))
#define XB_TMO      128
#define XB_XCNT(j)  (256  + 64 * (j))
#define XB_XSUB(j)  (1280 + 64 * (j))
#define XB_XGEN(j)  (2304 + 64 * (j))
#define XB_TOP      3328
#define XB_TOPGEN   3392
#define XCD_BAR_WORDS 3456
#define XB_SPIN_CAP (1u << 18)
__device__ __forceinline__ unsigned xb_ld(unsigned* p)              { return __hip_atomic_load(p, __ATOMIC_RELAXED, __HIP_MEMORY_SCOPE_AGENT); }
__device__ __forceinline__ unsigned xb_add(unsigned* p, unsigned v) { return __hip_atomic_fetch_add(p, v, __ATOMIC_RELAXED, __HIP_MEMORY_SCOPE_AGENT); }
__device__ __forceinline__ unsigned xb_xcc_id() { return (unsigned)__builtin_amdgcn_s_getreg((3 << 11) | 20) & 0xFu; }
#define XB_SPIN(cond, bar) do { unsigned _sp = 0; while (cond) { __builtin_amdgcn_s_sleep(1); \
    if ((++_sp & 255u) == 0u) { if (xb_ld(&(bar)[XB_TMO])) break; if (_sp > XB_SPIN_CAP) { atomicAdd(&(bar)[XB_TMO], 1u); break; } } } } while (0)
struct XcdBarrier { unsigned* bar; unsigned x; volatile LAS unsigned* st; };
__device__ __forceinline__ XcdBarrier xcd_barrier_post(unsigned* bar, volatile LAS unsigned* st) {
    XcdBarrier b; b.bar = bar; b.x = xb_xcc_id(); b.st = st;
    if (threadIdx.x == 0) (void)xb_add(&bar[XB_XCNT(b.x)], 1u);
    return b;
}
__device__ __forceinline__ void xcd_barrier_complete(unsigned* bar, unsigned x, unsigned& nloc, unsigned& nx) {
    const unsigned G = gridDim.x * gridDim.y * gridDim.z;
    unsigned sum, cnt, mine, sp = 0u;
    for (;;) {
        sum = 0u; cnt = 0u; mine = 0u;
#pragma unroll
        for (unsigned j = 0; j < 16; ++j) { const unsigned c = xb_ld(&bar[XB_XCNT(j)]); sum += c; cnt += (c > 0u) ? 1u : 0u; mine = (j == x) ? c : mine; }
        if (sum == G) break;
        __builtin_amdgcn_s_sleep(1);
        if ((++sp & 255u) == 0u) { if (xb_ld(&bar[XB_TMO])) break; if (sp > XB_SPIN_CAP) { atomicAdd(&bar[XB_TMO], 1u); break; } }
    }
    nloc = mine > 0u ? mine : 1u; nx = cnt > 0u ? cnt : 1u;
}
__device__ __forceinline__ void xcd_barrier(const XcdBarrier& b) {
    asm volatile("s_waitcnt vmcnt(0)" ::: "memory");
    __syncthreads();
    if (threadIdx.x == 0) {
        unsigned* bar = b.bar;
        __builtin_amdgcn_s_waitcnt(0);
        unsigned nloc = b.st[0], nx = b.st[1];
        if (nloc == 0u) { xcd_barrier_complete(bar, b.x, nloc, nx); b.st[0] = nloc; b.st[1] = nx; }
        const unsigned old = xb_add(&bar[XB_XSUB(b.x)], 1u);
        const unsigned gen = old / nloc;
        if (old + 1u == (gen + 1u) * nloc) {
            __builtin_amdgcn_fence(__ATOMIC_RELEASE, "agent");
            asm volatile("s_waitcnt vmcnt(0)" ::: "memory");
            const unsigned og = xb_add(&bar[XB_TOP], 1u);
            const unsigned tg = og / nx;
            if (og + 1u == (tg + 1u) * nx) xb_add(&bar[XB_TOPGEN], 1u);
            else XB_SPIN(xb_ld(&bar[XB_TOPGEN]) == tg, bar);
            __builtin_amdgcn_fence(__ATOMIC_ACQUIRE, "agent");
            xb_add(&bar[XB_XGEN(b.x)], 1u);
            asm volatile("s_waitcnt vmcnt(0)" ::: "memory");
        } else {
            XB_SPIN(xb_ld(&bar[XB_XGEN(b.x)]) == gen, bar);
            asm volatile("buffer_inv sc0" ::: "memory");
            asm volatile("s_waitcnt vmcnt(0)" ::: "memory");
        }
    }
    __syncthreads();
}
constexpr int CW_BAR = 4096;
constexpr size_t CTL_ZERO_BYTES = 65536;

#ifndef PROBE_NORM
#define PROBE_NORM 0
#endif
#ifndef EXTRA_BARRIERS
#define EXTRA_BARRIERS 0
#endif
#ifndef DUP_MASK_V
#define DUP_MASK_V 0ull
#endif
constexpr unsigned long long DUP_MASK = DUP_MASK_V;
template <int PH>
__device__ __forceinline__ void run_from(const Params& P, LAS unsigned char* lds, const XcdBarrier& bar) {
    if constexpr (PH == 0 && PROBE_P0R == 1) { probe_p0_readonly(P, lds); xcd_barrier(bar); }
    if constexpr (PH == PH_NORM0 && PROBE_NORM == 1) { norm_rows<false, true>(lds, (const float*)(P.ws + WS_XA), NR, P.norm_ffn, (const float*)(P.ws + WS_MOD), 3, (bf16_t*)(P.ws + WS_ABF), P.router, (float*)(P.ws + WS_AFF)); xcd_barrier(bar); }
    if constexpr (PH == PH_INPROJ && EXTRA_BARRIERS > 0) { for (int i = 0; i < EXTRA_BARRIERS; ++i) xcd_barrier(bar); }
    if constexpr ((DUP_MASK >> PH) & 1ull) { run_phase<PH>(P, lds); xcd_barrier(bar); }
    run_phase<PH>(P, lds);
    if constexpr (PH + 1 < PH_COUNT) { xcd_barrier(bar); run_from<PH + 1>(P, lds, bar); }
}
__global__ void __launch_bounds__(NTHR, 2) mega_kernel(Params P) {
    extern __shared__ __attribute__((aligned(16))) unsigned char lds_raw[];
    LAS unsigned char* lds = (LAS unsigned char*)lds_raw;
    volatile LAS unsigned* st = (volatile LAS unsigned*)(lds + LDS_BYTES - 64);
    if (threadIdx.x < 16) st[threadIdx.x] = 0u;
    __syncthreads();
    const XcdBarrier bar = xcd_barrier_post((unsigned*)(P.ws + WS_CTL) + CW_BAR, st);
    run_from<0>(P, lds, bar);
}

extern "C" void kernel_launch(void* const* d_in, const int* in_sizes, int n_in, void* d_out, int out_size, void* d_ws, size_t ws_size, hipStream_t stream) {
    static int grid = 0;
    if (grid == 0) {
        if (n_in != 19 || ws_size < WS_END) { fprintf(stderr, "kernel_launch: unexpected n_in %d / ws_size %zu (need %zu)\n", n_in, ws_size, (size_t)WS_END); grid = -1; return; }
        int dev = 0, cus = 0, per_cu = 0;
        if (hipGetDevice(&dev) != hipSuccess || hipDeviceGetAttribute(&cus, hipDeviceAttributeMultiprocessorCount, dev) != hipSuccess) { grid = -1; return; }
        if (hipFuncSetAttribute((const void*)mega_kernel, hipFuncAttributeMaxDynamicSharedMemorySize, LDS_BYTES) != hipSuccess) { fprintf(stderr, "kernel_launch: hipFuncSetAttribute failed\n"); grid = -1; return; }
        if (hipOccupancyMaxActiveBlocksPerMultiprocessor(&per_cu, (const void*)mega_kernel, NTHR, LDS_BYTES) != hipSuccess || per_cu < 1) { fprintf(stderr, "kernel_launch: occupancy query says %d blocks/CU\n", per_cu); (void)hipGetLastError(); grid = -1; return; }
        grid = cus;
    }
    if (grid < 0) return;
    (void)hipMemsetAsync(d_ws, 0, CTL_ZERO_BYTES, stream);
    Params P{};
    const float** pp = (const float**)&P;
    for (int i = 0; i < 19; ++i) pp[i] = (const float*)d_in[i];
    P.out = (float*)d_out; P.ws = (unsigned char*)d_ws;
    hipLaunchKernelGGL(mega_kernel, dim3(grid), dim3(NTHR), LDS_BYTES, stream, P);
}

#ifdef PHASE_KERNELS
template <int PH>
__global__ void __launch_bounds__(NTHR, 2) phase_kernel(Params P) {
    extern __shared__ __attribute__((aligned(16))) unsigned char lds_raw2[];
    run_phase<PH>(P, (LAS unsigned char*)lds_raw2);
}
#define INST(n) template __global__ void phase_kernel<n>(Params);
INST(0) INST(1) INST(2) INST(3) INST(4) INST(5) INST(6) INST(7) INST(8) INST(9) INST(10) INST(11) INST(12) INST(13) INST(14) INST(15) INST(16) INST(17)
#endif
```
